# Optimizing an MI355X kernel written in HIP

```python
import math
import jax, jax.numpy as jnp
from jax import lax
import numpy as np

D_MODEL = 1024
BATCH = 1
SEQ = 16384
DEPTH = 4

CHUNK = 64
QBLK = 128
POOL_WIDTH = D_MODEL
POOL_GROUPS = 4
POOL_GROUP = POOL_WIDTH // POOL_GROUPS
POOL_WINDOWS = (2, 4, 8, 16)
DIFF_QK_DIM = 128
DIFF_V_DIM = 2 * DIFF_QK_DIM
DIFF_HEADS = D_MODEL // DIFF_V_DIM
DIFF_QK_WIDTH = DIFF_HEADS * 2 * DIFF_QK_DIM
DIFF_V_WIDTH = DIFF_HEADS * DIFF_V_DIM
ROT_DIM = DIFF_QK_DIM // 4
ROPE_THETA = 500000.0
N_BRANCHES = 2
IN_WIDTH = POOL_WIDTH + 2 * DIFF_QK_WIDTH + DIFF_V_WIDTH + N_BRANCHES * D_MODEL
FFN_HIDDEN = -(-8 * D_MODEL // (3 * 256)) * 256
NORM_EPS = 1e-6

kernel_name = "hybrid_pool_diffattn_gated_block"


def rmsnorm(x, g):
    xf = x.astype(jnp.float32)
    y = xf * lax.rsqrt(jnp.mean(xf * xf, axis=-1, keepdims=True) + NORM_EPS)
    return (y * g.astype(jnp.float32)).astype(x.dtype)


def rotary_tables(seq, dtype):
    pos = jnp.arange(seq, dtype=jnp.float32)
    inv_freq = ROPE_THETA ** (-jnp.arange(0, ROT_DIM, 2, dtype=jnp.float32) / ROT_DIM)
    ang = pos[:, None] * inv_freq[None, :]
    return jnp.cos(ang).astype(dtype), jnp.sin(ang).astype(dtype)


def apply_partial_rotary(t, cos, sin):
    half = ROT_DIM // 2
    t1, t2, rest = t[..., :half], t[..., half:ROT_DIM], t[..., ROT_DIM:]
    return jnp.concatenate([t1 * cos - t2 * sin, t2 * cos + t1 * sin, rest], axis=-1)


def pool_mixer(u, w_pool, scale):
    b, s, _ = u.shape
    ug = u.reshape(b, s, POOL_GROUPS, POOL_GROUP)
    t_idx = jnp.arange(s, dtype=jnp.float32)[None, :, None]
    outs = []
    for gi, w in enumerate(POOL_WINDOWS):
        xg = ug[:, :, gi, :].astype(jnp.float32)
        c = jnp.cumsum(xg, axis=1)
        c_shift = jnp.pad(c, ((0, 0), (w, 0), (0, 0)))[:, :s]
        count = jnp.minimum(t_idx + 1.0, float(w))
        outs.append((c - c_shift) / count - xg)
    pooled = jnp.stack(outs, axis=2).astype(u.dtype)
    y = jnp.einsum('bsgc,gcd->bsgd', pooled, w_pool)
    return y.reshape(b, s, POOL_WIDTH) * scale


def diff_attention(q, k, v, lam):
    b, h, _, s, d = q.shape
    nblk = s // QBLK
    chunk_ids = jnp.arange(s) // CHUNK
    qb = q.reshape(b, h, 2, nblk, QBLK, d).transpose(3, 0, 1, 2, 4, 5)
    qc = chunk_ids.reshape(nblk, QBLK)
    scale = DIFF_QK_DIM ** -0.5
    neg = jnp.finfo(jnp.float32).min

    def one_block(args):
        qi, ci = args
        sc = jnp.einsum('bhcqd,bhckd->bhcqk', qi, k).astype(jnp.float32) * scale
        mask = ci[:, None] >= chunk_ids[None, :]
        p = jax.nn.softmax(jnp.where(mask, sc, neg), axis=-1)
        a = p[:, :, 0] - lam * p[:, :, 1]
        return jnp.einsum('bhqk,bhkv->bhqv', a.astype(v.dtype), v)

    out = lax.map(one_block, (qb, qc))
    return out.transpose(1, 2, 0, 3, 4).reshape(b, h, s, DIFF_V_DIM)


def setup_inputs(seed: int = 0) -> dict:
    key = jax.random.key(seed)
    ks = jax.random.split(key, 16)
    f32 = jnp.float32
    nrm = lambda k, shp, std: jax.random.normal(k, shp, f32) * std
    return {
        "x": jax.random.normal(ks[0], (BATCH, SEQ, D_MODEL), f32),
        "norm1_g": 1.0 + nrm(ks[1], (DEPTH, D_MODEL), 0.02),
        "w_in": nrm(ks[2], (DEPTH, D_MODEL, IN_WIDTH), D_MODEL ** -0.5),
        "q_norm_g": 1.0 + nrm(ks[3], (DEPTH, DIFF_QK_DIM), 0.02),
        "k_norm_g": 1.0 + nrm(ks[4], (DEPTH, DIFF_QK_DIM), 0.02),
        "lam_q1": nrm(ks[5], (DEPTH, DIFF_QK_DIM), 0.1),
        "lam_k1": nrm(ks[6], (DEPTH, DIFF_QK_DIM), 0.1),
        "lam_q2": nrm(ks[7], (DEPTH, DIFF_QK_DIM), 0.1),
        "lam_k2": nrm(ks[8], (DEPTH, DIFF_QK_DIM), 0.1),
        "subln_g": 1.0 + nrm(ks[9], (DEPTH, DIFF_V_DIM), 0.02),
        "pool_w": nrm(ks[10], (DEPTH, POOL_GROUPS, POOL_GROUP, POOL_GROUP), POOL_GROUP ** -0.5),
        "pool_scale": 1.0 + nrm(ks[11], (DEPTH, POOL_WIDTH), 0.02),
        "w_out": nrm(ks[12], (DEPTH, D_MODEL, D_MODEL), D_MODEL ** -0.5),
        "norm2_g": 1.0 + nrm(ks[13], (DEPTH, D_MODEL), 0.02),
        "w_ffn_in": nrm(ks[14], (DEPTH, D_MODEL, 2 * FFN_HIDDEN), D_MODEL ** -0.5),
        "w_ffn_out": nrm(ks[15], (DEPTH, FFN_HIDDEN, D_MODEL), FFN_HIDDEN ** -0.5),
    }


def reference(x, norm1_g, w_in, q_norm_g, k_norm_g, lam_q1, lam_k1, lam_q2, lam_k2,
              subln_g, pool_w, pool_scale, w_out, norm2_g, w_ffn_in, w_ffn_out):
    b, s, _ = x.shape
    cos, sin = rotary_tables(s, x.dtype)
    splits = np.cumsum([POOL_WIDTH, DIFF_QK_WIDTH, DIFF_QK_WIDTH, DIFF_V_WIDTH, D_MODEL]).tolist()
    for i in range(DEPTH):
        lam_init = 0.8 - 0.6 * math.exp(-0.3 * i)
        xn = rmsnorm(x, norm1_g[i])
        proj = xn @ w_in[i]
        u_pool, q, k, v, g_a, g_b = jnp.split(proj, splits, axis=-1)
        q = q.reshape(b, s, DIFF_HEADS, 2, DIFF_QK_DIM).transpose(0, 2, 3, 1, 4)
        k = k.reshape(b, s, DIFF_HEADS, 2, DIFF_QK_DIM).transpose(0, 2, 3, 1, 4)
        q = apply_partial_rotary(rmsnorm(q, q_norm_g[i]), cos, sin)
        k = apply_partial_rotary(rmsnorm(k, k_norm_g[i]), cos, sin)
        v = v.reshape(b, s, DIFF_HEADS, DIFF_V_DIM).transpose(0, 2, 1, 3)
        lam = (jnp.exp(jnp.sum(lam_q1[i].astype(jnp.float32) * lam_k1[i].astype(jnp.float32)))
               - jnp.exp(jnp.sum(lam_q2[i].astype(jnp.float32) * lam_k2[i].astype(jnp.float32)))
               + lam_init)
        o = diff_attention(q, k, v, lam)
        o = rmsnorm(o, subln_g[i]) * (1.0 - lam_init)
        attn_out = o.transpose(0, 2, 1, 3).reshape(b, s, DIFF_V_WIDTH)
        pool_out = pool_mixer(u_pool, pool_w[i], pool_scale[i])
        merged = jax.nn.sigmoid(g_a) * pool_out + jax.nn.sigmoid(g_b) * attn_out
        x = x + merged @ w_out[i]
        hn = rmsnorm(x, norm2_g[i])
        gate, up = jnp.split(hn @ w_ffn_in[i], 2, axis=-1)
        x = x + (jax.nn.silu(gate) * up) @ w_ffn_out[i]
    return x
```

```cpp
#include <hip/hip_runtime.h>
#include <hip/hip_cooperative_groups.h>
#include <cstdio>
#include <cstdint>
#include <cmath>
namespace cg = cooperative_groups;

#define LAS __attribute__((address_space(3)))
typedef unsigned short bf16_t;
typedef short bf16x8 __attribute__((ext_vector_type(8)));
typedef float f32x4 __attribute__((ext_vector_type(4)));
typedef float f32x16 __attribute__((ext_vector_type(16)));
typedef unsigned u32x4 __attribute__((ext_vector_type(4)));
typedef unsigned u32x2 __attribute__((ext_vector_type(2)));

constexpr int M = 16384, D = 1024, NIN = 6144, FF = 2816, NFF2 = 5632, DEPTH = 4;
constexpr float NORM_EPS = 1e-6f;
constexpr float QSC = 0.08838834764831845f * 1.4426950408889634f;
constexpr size_t ACT_ELEMS = (size_t)M * D;

constexpr size_t MiB = 1u << 20;
constexpr size_t SZ_WIN = (size_t)NIN * D * 2, SZ_WOUT = (size_t)D * D * 2, SZ_WFF = (size_t)NFF2 * D * 2, SZ_WFO = (size_t)D * FF * 2, SZ_POOL = 4 * 256 * 256 * 2;
constexpr size_t OFF_WIN = 0, OFF_WOUT = OFF_WIN + SZ_WIN, OFF_WFF = OFF_WOUT + SZ_WOUT, OFF_WFO = OFF_WFF + SZ_WFF, OFF_POOL = OFF_WFO + SZ_WFO, LAYER_W = OFF_POOL + SZ_POOL;
static_assert(LAYER_W == 31 * MiB, "weights per layer");
constexpr size_t WS_W = 0;
constexpr size_t WS_ACT = 124 * MiB;
constexpr size_t WS_ATTN = WS_ACT + 6 * 32 * MiB;
constexpr size_t WS_XB = WS_ATTN + 32 * MiB;
constexpr size_t WS_SSQ = WS_XB + 32 * MiB;
constexpr size_t WS_COS = WS_SSQ + 4 * M * 4;
constexpr size_t WS_SIN = WS_COS + (size_t)M * 16 * 4;
constexpr size_t WS_BAR = WS_SIN + (size_t)M * 16 * 4;
constexpr size_t WS_BAR_BYTES = 16384;
constexpr size_t WS_END = WS_BAR + WS_BAR_BYTES;
constexpr size_t WS_FFACT = WS_ACT;
constexpr size_t WS_MERGED = WS_ACT + 32 * MiB;
constexpr size_t WS_POOLED = WS_ACT + 64 * MiB;
static_assert((size_t)M * FF * 2 <= 96 * MiB, "ffn activation overlay");

constexpr int RING_BYTES = 131072, XL_OFF = RING_BYTES, XL_BYTES = 8192, LDS_BYTES = 147456;
constexpr int NWAVES = 8, NTHREADS = 512, GRID = 256;

__device__ __forceinline__ unsigned cvt_pk_bf16(float lo, float hi) { unsigned r; asm volatile("v_cvt_pk_bf16_f32 %0, %1, %2" : "=v"(r) : "v"(lo), "v"(hi)); return r; }
__device__ __forceinline__ float bf_lo(unsigned w) { return __uint_as_float(w << 16); }
__device__ __forceinline__ float bf_hi(unsigned w) { return __uint_as_float(w & 0xffff0000u); }
__device__ __forceinline__ u32x4 pack8(const f32x4 a, const f32x4 b) { u32x4 w; w.x = cvt_pk_bf16(a[0], a[1]); w.y = cvt_pk_bf16(a[2], a[3]); w.z = cvt_pk_bf16(b[0], b[1]); w.w = cvt_pk_bf16(b[2], b[3]); return w; }
__device__ __forceinline__ void unpack8(const u32x4 w, f32x4& a, f32x4& b) { a = (f32x4){bf_lo(w.x), bf_hi(w.x), bf_lo(w.y), bf_hi(w.y)}; b = (f32x4){bf_lo(w.z), bf_hi(w.z), bf_lo(w.w), bf_hi(w.w)}; }
__device__ __forceinline__ float sigmoidf_(float x) { return __builtin_amdgcn_rcpf(1.0f + __builtin_amdgcn_exp2f(-1.4426950408889634f * x)); }
__device__ __forceinline__ int lane_id() { int r; asm volatile("v_mbcnt_lo_u32_b32 %0, -1, 0\n\tv_mbcnt_hi_u32_b32 %0, -1, %0" : "=v"(r)); return r; }
#define XB_TMO      128
#define XB_XCNT(j)  (256  + 64 * (j))
#define XB_XSUB(j)  (1280 + 64 * (j))
#define XB_XGEN(j)  (2304 + 64 * (j))
#define XB_TOP      3328
#define XB_TOPGEN   3392
#define XCD_BAR_WORDS 3456
#define XB_SPIN_CAP (1u << 22)
__device__ __forceinline__ unsigned xb_ld(unsigned* p)              { return __hip_atomic_load(p, __ATOMIC_RELAXED, __HIP_MEMORY_SCOPE_AGENT); }
__device__ __forceinline__ unsigned xb_add(unsigned* p, unsigned v) { return __hip_atomic_fetch_add(p, v, __ATOMIC_RELAXED, __HIP_MEMORY_SCOPE_AGENT); }
__device__ __forceinline__ unsigned xb_xcc_id() { return (unsigned)__builtin_amdgcn_s_getreg((3 << 11) | 20) & 0xFu; }
#define XB_SPIN(cond, bar) do { unsigned _sp = 0; while (cond) { __builtin_amdgcn_s_sleep(1); \
    if ((++_sp & 255u) == 0u) { if (xb_ld(&(bar)[XB_TMO])) break; if (_sp > XB_SPIN_CAP) { atomicAdd(&(bar)[XB_TMO], 1u); break; } } } } while (0)
__device__ __forceinline__ void xcd_barrier_complete(unsigned* bar, unsigned x, unsigned& nloc, unsigned& nx) {
    const unsigned G = gridDim.x;
    unsigned sum, cnt, mine, sp = 0u;
    for (;;) {
        sum = 0u; cnt = 0u; mine = 0u;
#pragma unroll
        for (unsigned j = 0; j < 16; ++j) { const unsigned c = xb_ld(&bar[XB_XCNT(j)]); sum += c; cnt += (c > 0u) ? 1u : 0u; mine = (j == x) ? c : mine; }
        if (sum == G) break;
        __builtin_amdgcn_s_sleep(1);
        if ((++sp & 255u) == 0u) { if (xb_ld(&bar[XB_TMO])) break; if (sp > XB_SPIN_CAP) { atomicAdd(&bar[XB_TMO], 1u); break; } }
    }
    nloc = mine > 0u ? mine : 1u; nx = cnt > 0u ? cnt : 1u;
}
__device__ __forceinline__ void grid_barrier(unsigned* bar, volatile LAS unsigned* st, int wv) {
    asm volatile("s_waitcnt vmcnt(0) lgkmcnt(0)" ::: "memory");
    __syncthreads();
    if (wv == 0) {
        if (lane_id() == 0) {
            const unsigned x = xb_xcc_id();
            unsigned nloc = st[0], nx = st[1];
            if (nloc == 0u) { xcd_barrier_complete(bar, x, nloc, nx); st[0] = nloc; st[1] = nx; }
            const unsigned old = xb_add(&bar[XB_XSUB(x)], 1u);
            const unsigned gen = old / nloc;
            if (old + 1u == (gen + 1u) * nloc) {
                __builtin_amdgcn_fence(__ATOMIC_RELEASE, "agent");
                asm volatile("s_waitcnt vmcnt(0)" ::: "memory");
                const unsigned og = xb_add(&bar[XB_TOP], 1u);
                const unsigned tg = og / nx;
                if (og + 1u == (tg + 1u) * nx) xb_add(&bar[XB_TOPGEN], 1u);
                else XB_SPIN(xb_ld(&bar[XB_TOPGEN]) == tg, bar);
                __builtin_amdgcn_fence(__ATOMIC_ACQUIRE, "agent");
                xb_add(&bar[XB_XGEN(x)], 1u);
                asm volatile("s_waitcnt vmcnt(0)" ::: "memory");
            } else {
                XB_SPIN(xb_ld(&bar[XB_XGEN(x)]) == gen, bar);
                __builtin_amdgcn_fence(__ATOMIC_ACQUIRE, "agent");
                asm volatile("s_waitcnt vmcnt(0)" ::: "memory");
            }
        }
    }
    __syncthreads();
}
__device__ __forceinline__ float xor32_sum(float v) { auto rr = __builtin_amdgcn_permlane32_swap(__float_as_uint(v), __float_as_uint(v), false, false); return __uint_as_float(rr[0]) + __uint_as_float(rr[1]); }
__device__ __forceinline__ float xor32_get(float v, int hi) { auto rr = __builtin_amdgcn_permlane32_swap(__float_as_uint(v), __float_as_uint(v), false, false); return hi ? __uint_as_float(rr[0]) : __uint_as_float(rr[1]); }
__device__ __forceinline__ float xor16_sum(float v) { return v + __uint_as_float((unsigned)__builtin_amdgcn_ds_swizzle((int)__float_as_uint(v), 0x401F)); }
__device__ __forceinline__ float wave_sum_rl(float v) { float s = 0.f;
#pragma unroll
    for (int i = 0; i < 64; ++i) s += __uint_as_float((unsigned)__builtin_amdgcn_readlane((int)__float_as_uint(v), i));
    return s; }
__device__ __forceinline__ float wave_max_rl(float v) { float s = 0.f;
#pragma unroll
    for (int i = 0; i < 64; ++i) s = fmaxf(s, __uint_as_float((unsigned)__builtin_amdgcn_readlane((int)__float_as_uint(v), i)));
    return s; }
#define LDS_BAR() do { asm volatile("s_waitcnt lgkmcnt(0)" ::: "memory"); __builtin_amdgcn_s_barrier(); asm volatile("" ::: "memory"); } while (0)

namespace pg8 {
constexpr int BM = 256, BK = 64, HALF = 128, HTB = HALF * BK * 2, NXCD = 8, WGM = 8;
__device__ __forceinline__ int lds_byte(int r, int c) { const int st = (r >> 4) * 2 + (c >> 5), rr = r & 15, cc = c & 31, ob = rr * 64 + cc * 2; return st * 1024 + (ob ^ (((ob >> 9) & 1) << 5)); }
__device__ __forceinline__ void stage_rc(int b, int& R, int& C) { const int st = b / 1024, sb = b % 1024, swz = sb ^ (((sb >> 9) & 1) << 5); R = (st >> 1) * 16 + swz / 64; C = (st & 1) * 32 + (swz % 64) / 2; }
__device__ __forceinline__ int perm32(int rho) { const int n = rho >> 4, i = rho & 15; return 8 * (i >> 2) + 4 * n + (i & 3); }

struct Unit { int pm, pn; };
struct Gemm { const bf16_t* A; const bf16_t* Bt; int lda, ldb, K, a_cpn; };

struct StaticOrder {
    int nM, nN, nwg, G, c;
    __device__ void init(int M_, int N_, int G_, int c_) { nM = M_ / BM; nN = N_ / BM; nwg = nM * nN; G = G_; c = c_; }
    __device__ bool next(int i, Unit& u) const {
        const long L = (long)i * G + c; if (L >= nwg) return false;
        int wgid = (int)L; { const int q = nwg / NXCD, r = nwg % NXCD, xcd = wgid % NXCD, off = wgid / NXCD; wgid = (xcd < r ? xcd * (q + 1) : r * (q + 1) + (xcd - r) * q) + off; }
        const int nig = WGM * nN, gid = wgid / nig, fm = gid * WGM, gsz = (nM - fm) < WGM ? (nM - fm) : WGM;
        u.pm = fm + ((wgid % nig) % gsz); u.pn = (wgid % nig) / gsz; return true;
    }
};


struct EpiIn {
    static constexpr bool PERM = true, AFTER_DRAIN = false;
    unsigned char* ws; const float* gq; const float* gk; LAS float* xl;
    __device__ __forceinline__ void operator()(f32x4 (&acc)[2][2][4][2], const Unit& u, int wr, int wc, int fr, int fq, int wid, int lane, int ui) const {
        bf16_t* out0 = (bf16_t*)(ws + WS_ACT); const float* rcos = (const float*)(ws + WS_COS); const float* rsin = (const float*)(ws + WS_SIN);
        const LAS float* rsl = xl + XL_BYTES / 4 + ui * 256;
        const int kind = u.pn >> 2, cb = (u.pn & 3) * 256;
        bf16_t* dst = out0 + (size_t)kind * ACT_ELEMS;
        const int row0 = u.pm * BM + wr * 64 + fr, colw = wc * 32 + 8 * fq;
#pragma unroll
        for (int ai = 0; ai < 2; ++ai)
#pragma unroll
            for (int m = 0; m < 4; ++m) {
                const float rs = rsl[ai * HALF + wr * 64 + m * 16 + fr];
#pragma unroll
                for (int bj = 0; bj < 2; ++bj)
#pragma unroll
                    for (int n = 0; n < 2; ++n) acc[ai][bj][m][n] *= rs;
                if (m & 1) __builtin_amdgcn_sched_barrier(0);
            }
        if (kind == 1 || kind == 2) {
            const float* g = (kind == 1) ? gq : gk;
#pragma unroll
            for (int ai = 0; ai < 2; ++ai)
#pragma unroll
                for (int m = 0; m < 4; ++m)
#pragma unroll
                    for (int bj = 0; bj < 2; ++bj) {
                        const f32x4 a = acc[ai][bj][m][0], b = acc[ai][bj][m][1];
                        float ss = (a[0] * a[0] + a[1] * a[1]) + (a[2] * a[2] + a[3] * a[3]) + (b[0] * b[0] + b[1] * b[1]) + (b[2] * b[2] + b[3] * b[3]);
                        ss = xor32_sum(xor16_sum(ss));
                        if (fq == 0) xl[((ai * HALF + wr * 64 + m * 16 + fr) * 2 + bj) * 4 + wc] = ss;
                    }
            LDS_BAR();
            const f32x4 g0 = *(const f32x4*)(g + colw), g1 = *(const f32x4*)(g + colw + 4);
            const float osc = (kind == 1) ? QSC : 1.0f;
            const float sgn = (fq < 2) ? -1.0f : 1.0f;
#pragma unroll
            for (int ai = 0; ai < 2; ++ai)
#pragma unroll
                for (int m = 0; m < 4; ++m) {
                    const int rt = ai * HALF + wr * 64 + m * 16 + fr, r = u.pm * BM + rt;
                    f32x4 c0, c1, s0, s1;
                    if (wc == 0) { const int j0 = 8 * (fq & 1); c0 = *(const f32x4*)(rcos + (size_t)r * 16 + j0); c1 = *(const f32x4*)(rcos + (size_t)r * 16 + j0 + 4);
                                   s0 = *(const f32x4*)(rsin + (size_t)r * 16 + j0); s1 = *(const f32x4*)(rsin + (size_t)r * 16 + j0 + 4); }
#pragma unroll
                    for (int bj = 0; bj < 2; ++bj) {
                        const f32x4 t4 = *(const LAS f32x4*)(xl + (rt * 2 + bj) * 4);
                        const float rn = __builtin_amdgcn_rsqf(((t4[0] + t4[1]) + (t4[2] + t4[3])) * (1.0f / 128.0f) + NORM_EPS);
                        f32x4 v0 = acc[ai][bj][m][0] * rn * g0, v1 = acc[ai][bj][m][1] * rn * g1;
                        if (wc == 0) {
                            f32x4 p0, p1;
#pragma unroll
                            for (int i = 0; i < 4; ++i) { p0[i] = xor32_get(v0[i], fq >> 1); p1[i] = xor32_get(v1[i], fq >> 1); }
                            v0 = v0 * c0 + (p0 * s0) * sgn; v1 = v1 * c1 + (p1 * s1) * sgn;
                        }
                        v0 *= osc; v1 *= osc;
                        *(u32x4*)(dst + (size_t)r * D + cb + bj * HALF + colw) = pack8(v0, v1);
                    }
                    __builtin_amdgcn_sched_barrier(0);
                }
        } else {
            const bool sg = kind >= 4;
#pragma unroll
            for (int ai = 0; ai < 2; ++ai)
#pragma unroll
                for (int m = 0; m < 4; ++m) {
                    const int r = row0 + ai * HALF + m * 16;
#pragma unroll
                    for (int bj = 0; bj < 2; ++bj) {
                        f32x4 v0 = acc[ai][bj][m][0], v1 = acc[ai][bj][m][1];
                        if (sg) {
#pragma unroll
                            for (int i = 0; i < 4; ++i) { v0[i] = sigmoidf_(v0[i]); v1[i] = sigmoidf_(v1[i]); }
                        }
                        *(u32x4*)(dst + (size_t)r * D + cb + bj * HALF + colw) = pack8(v0, v1);
                    }
                }
        }
    }
};

struct EpiSwiGLU {
    static constexpr bool PERM = true, AFTER_DRAIN = false;
    bf16_t* act; LAS float* xl;
    __device__ __forceinline__ void operator()(f32x4 (&acc)[2][2][4][2], const Unit& u, int wr, int wc, int fr, int fq, int wid, int lane, int ui) const {
        const int row0 = u.pm * BM + wr * 64 + fr, col = u.pn * HALF + wc * 32 + 8 * fq;
#pragma unroll
        for (int ai = 0; ai < 2; ++ai)
#pragma unroll
            for (int m = 0; m < 4; ++m) {
                const int r = row0 + ai * HALF + m * 16;
                const float rs = xl[XL_BYTES / 4 + ui * 256 + ai * HALF + wr * 64 + m * 16 + fr];
                f32x4 o[2];
#pragma unroll
                for (int n = 0; n < 2; ++n) {
                    const f32x4 gt = acc[ai][0][m][n] * rs, up = acc[ai][1][m][n] * rs;
#pragma unroll
                    for (int i = 0; i < 4; ++i) o[n][i] = gt[i] * sigmoidf_(gt[i]) * up[i];
                }
                *(u32x4*)(act + (size_t)r * FF + col) = pack8(o[0], o[1]);
            }
    }
};

struct EpiMerge {
    static constexpr bool PERM = true, AFTER_DRAIN = true;
    const bf16_t* sga; const bf16_t* sgb; const bf16_t* attn; const float* pscale; bf16_t* merged;
    __device__ __forceinline__ void operator()(f32x4 (&acc)[2][2][4][2], const Unit& u, int wr, int wc, int fr, int fq, int wid, int lane, int ui) const {
        const int row0 = u.pm * BM + wr * 64 + fr;
#pragma unroll
        for (int bj = 0; bj < 2; ++bj) {
            const int col = u.pn * BM + bj * HALF + wc * 32 + 8 * fq;
            const f32x4 ps0 = *(const f32x4*)(pscale + col), ps1 = *(const f32x4*)(pscale + col + 4);
#pragma unroll
            for (int ai = 0; ai < 2; ++ai)
#pragma unroll
                for (int m = 0; m < 4; ++m) {
                    const size_t off = (size_t)(row0 + ai * HALF + m * 16) * D + col;
                    const u32x4 wa = *(const u32x4*)(sga + off), wb = *(const u32x4*)(sgb + off), wt = *(const u32x4*)(attn + off);
                    f32x4 a0, a1, b0, b1, t0, t1; unpack8(wa, a0, a1); unpack8(wb, b0, b1); unpack8(wt, t0, t1);
                    const f32x4 o0 = a0 * (acc[ai][bj][m][0] * ps0) + b0 * t0, o1 = a1 * (acc[ai][bj][m][1] * ps1) + b1 * t1;
                    *(u32x4*)(merged + off) = pack8(o0, o1);
                }
        }
    }
};

__device__ __forceinline__ float swz_sum32(float v) {
    v += __uint_as_float((unsigned)__builtin_amdgcn_ds_swizzle((int)__float_as_uint(v), 0x041F));
    v += __uint_as_float((unsigned)__builtin_amdgcn_ds_swizzle((int)__float_as_uint(v), 0x081F));
    v += __uint_as_float((unsigned)__builtin_amdgcn_ds_swizzle((int)__float_as_uint(v), 0x101F));
    v += __uint_as_float((unsigned)__builtin_amdgcn_ds_swizzle((int)__float_as_uint(v), 0x201F));
    v += __uint_as_float((unsigned)__builtin_amdgcn_ds_swizzle((int)__float_as_uint(v), 0x401F));
    return v;
}
struct EpiRes {
    static constexpr bool PERM = false, AFTER_DRAIN = true;
    const float* res; float* out; bf16_t* xb; float* ssq; LAS unsigned char* lds;
    __device__ __forceinline__ void operator()(f32x4 (&acc)[2][2][4][2], const Unit& u, int wr, int wc, int fr, int fq, int wid, int lane, int ui) const {
        constexpr int RS = 1040;
#pragma unroll
        for (int ai = 0; ai < 2; ++ai) {
#pragma unroll
            for (int m = 0; m < 4; ++m)
#pragma unroll
                for (int bj = 0; bj < 2; ++bj)
#pragma unroll
                    for (int n = 0; n < 2; ++n)
                        *(LAS f32x4*)(lds + (wr * 64 + m * 16 + fr) * RS + (bj * HALF + wc * 32 + n * 16 + 4 * fq) * 4) = acc[ai][bj][m][n];
            LDS_BAR();
#pragma unroll 1
            for (int c = 0; c < 2; ++c) {
                f32x4 rv[8];
#pragma unroll
                for (int rr = 0; rr < 8; ++rr) { const size_t grow = (size_t)(u.pm * BM + ai * HALF + wid * 16 + c * 8 + rr); rv[rr] = *((const f32x4*)(res + grow * D + u.pn * BM) + lane); }
#pragma unroll
                for (int rr = 0; rr < 8; ++rr) {
                    const int rl = wid * 16 + c * 8 + rr; const size_t grow = (size_t)(u.pm * BM + ai * HALF + rl);
                    const f32x4 v = rv[rr] + *(const LAS f32x4*)(lds + rl * RS + lane * 16);
                    *((f32x4*)(out + grow * D + u.pn * BM) + lane) = v;
                    u32x2 w; w.x = cvt_pk_bf16(v[0], v[1]); w.y = cvt_pk_bf16(v[2], v[3]);
                    *((u32x2*)(xb + grow * D + u.pn * BM) + lane) = w;
                    float ss = (v[0] * v[0] + v[1] * v[1]) + (v[2] * v[2] + v[3] * v[3]);
                    ss = xor32_sum(swz_sum32(ss));
                    if (lane == 0) ssq[(size_t)u.pn * M + grow] = ss;
                }
            }
            LDS_BAR();
        }
    }
};

template <class Epi, bool ALIGN_EPI>
__device__ __forceinline__ void gemm_phase(LAS unsigned char* lds, const Gemm g, const StaticOrder& S, const Epi& E, int wv) {
    int tid_ = (wv << 6) | lane_id(); asm volatile("" : "+v"(tid_));
    const int tid = tid_, wid = __builtin_amdgcn_readfirstlane(tid >> 6), lane = tid & 63, wr = wid >> 2, wc = wid & 3, fr = lane & 15, fq = lane >> 4;
    const int K = g.K, nt = K / BK;
    unsigned voffA[2], voffB[2];
#pragma unroll
    for (int i = 0; i < 2; ++i) { int R, C; stage_rc(tid * 16 + i * 8192, R, C); const int Rb = Epi::PERM ? ((R & ~31) + perm32(R & 31)) : R;
        voffA[i] = (unsigned)(R * g.lda + C) * 2u; voffB[i] = (unsigned)(Rb * g.ldb + C) * 2u; }
    const size_t kstep = (size_t)(BK * 2);
    const size_t hstepA = (size_t)HALF * g.lda * 2, hstepB = (size_t)HALF * g.ldb * 2;
    const unsigned ldsw = (unsigned)wid * 1024u;
    const int aoff = lds_byte(wr * 64 + fr, fq * 8), boff = lds_byte(wc * 32 + fr, fq * 8);
#define PG8_SA(b, h) (((b) * 2 + (h)) * HTB)
#define PG8_SB(b, h) ((4 + (b) * 2 + (h)) * HTB)
#define PG8_STAGE(bufoff, gbase, voff) do { _Pragma("unroll") for (int _i = 0; _i < 2; ++_i) \
        __builtin_amdgcn_global_load_lds((const unsigned*)((const char*)(gbase) + (voff)[_i]), (LAS unsigned*)(lds + (bufoff) + ldsw + _i * 8192), 16, 0, 0); } while (0)
#define PG8_LDA(dst, b, h) do { _Pragma("unroll") for (int m = 0; m < 4; ++m) _Pragma("unroll") for (int k = 0; k < 2; ++k) dst[m][k] = *(const LAS bf16x8*)(lds + PG8_SA(b, h) + aoff + m * 2048 + k * 1024); } while (0)
#define PG8_LDB(dst, b, h) do { _Pragma("unroll") for (int n = 0; n < 2; ++n) _Pragma("unroll") for (int k = 0; k < 2; ++k) dst[n][k] = *(const LAS bf16x8*)(lds + PG8_SB(b, h) + boff + n * 2048 + k * 1024); } while (0)
#define PG8_MMA(ai, bj, At, Bt) do { __builtin_amdgcn_s_setprio(1); _Pragma("unroll") for (int m = 0; m < 4; ++m) _Pragma("unroll") for (int n = 0; n < 2; ++n) _Pragma("unroll") for (int k = 0; k < 2; ++k) \
        acc[ai][bj][m][n] = __builtin_amdgcn_mfma_f32_16x16x32_bf16(Bt[n][k], At[m][k], acc[ai][bj][m][n], 0, 0, 0); __builtin_amdgcn_s_setprio(0); } while (0)
#define PG8_WAIT_V(n) asm volatile("s_waitcnt vmcnt(" #n ")" ::: "memory")
#define PG8_WAIT_L(n) asm volatile("s_waitcnt lgkmcnt(" #n ")" ::: "memory")
#define PG8_BAR __builtin_amdgcn_s_barrier()
#define PG8_SCHED __builtin_amdgcn_sched_barrier(0)
#define PG8_UA(u_) ((const char*)g.A + ((size_t)(u_).pm * BM * g.lda + (size_t)(u_).pn * g.a_cpn) * 2)
#define PG8_UB(u_) ((const char*)g.Bt + (size_t)(u_).pn * BM * g.ldb * 2)
    Unit cur, nxt; int ui = 0;
    (void)S.next(0, cur);
    f32x4 acc[2][2][4][2];
#pragma unroll
    for (int a = 0; a < 2; ++a)
#pragma unroll
        for (int b = 0; b < 2; ++b)
#pragma unroll
            for (int m = 0; m < 4; ++m)
#pragma unroll
                for (int n = 0; n < 2; ++n) acc[a][b][m][n] = (f32x4){0.f, 0.f, 0.f, 0.f};
    bf16x8 At[4][2], B0[2][2], B1[2][2];
    const char* cA = PG8_UA(cur); const char* cB = PG8_UB(cur);
    PG8_STAGE(PG8_SB(0, 0), cB, voffB); PG8_STAGE(PG8_SB(0, 1), cB + hstepB, voffB); PG8_STAGE(PG8_SA(0, 0), cA, voffA); PG8_STAGE(PG8_SA(0, 1), cA + hstepA, voffA);
    if (wr == 1) PG8_BAR;
    PG8_WAIT_V(2); PG8_BAR;
    PG8_STAGE(PG8_SB(1, 0), cB + kstep, voffB); PG8_STAGE(PG8_SA(1, 0), cA + kstep, voffA); PG8_STAGE(PG8_SB(1, 1), cB + hstepB + kstep, voffB);
    PG8_WAIT_V(6); PG8_BAR;
    for (;;) {
        const bool has_next = S.next(ui + 1, nxt);
        const char* nA = has_next ? PG8_UA(nxt) : cA; const char* nB = has_next ? PG8_UB(nxt) : cB;
        for (int t = 0; t < nt; t += 2) {
            const bool last = (t == nt - 2);
            const char* a1 = cA + (size_t)(t + 1) * kstep;
            const char* a2 = last ? nA : cA + (size_t)(t + 2) * kstep; const char* b2 = last ? nB : cB + (size_t)(t + 2) * kstep;
            const char* a3 = a2 + kstep; const char* b3 = b2 + kstep;
            PG8_LDB(B0, 0, 0); PG8_LDB(B1, 0, 1); PG8_SCHED; PG8_LDA(At, 0, 0); PG8_STAGE(PG8_SA(1, 1), a1 + hstepA, voffA);
            PG8_WAIT_V(8); PG8_WAIT_L(0); PG8_BAR; PG8_MMA(0, 0, At, B0); PG8_MMA(0, 1, At, B1); PG8_BAR; PG8_SCHED;
            PG8_LDA(At, 0, 1); PG8_STAGE(PG8_SB(0, 0), b2, voffB); PG8_STAGE(PG8_SB(0, 1), b2 + hstepB, voffB); PG8_STAGE(PG8_SA(0, 0), a2, voffA);
            PG8_WAIT_V(8); PG8_WAIT_L(0); PG8_BAR; PG8_MMA(1, 0, At, B0); PG8_MMA(1, 1, At, B1); PG8_BAR; PG8_SCHED;
            PG8_LDB(B0, 1, 0); PG8_LDB(B1, 1, 1); PG8_SCHED; PG8_LDA(At, 1, 0); PG8_STAGE(PG8_SA(0, 1), a2 + hstepA, voffA);
            PG8_WAIT_V(8); PG8_WAIT_L(0); PG8_BAR; PG8_MMA(0, 0, At, B0); PG8_MMA(0, 1, At, B1); PG8_BAR; PG8_SCHED;
            PG8_LDA(At, 1, 1); PG8_STAGE(PG8_SB(1, 0), b3, voffB); PG8_STAGE(PG8_SB(1, 1), b3 + hstepB, voffB); PG8_STAGE(PG8_SA(1, 0), a3, voffA);
            PG8_WAIT_V(8); PG8_WAIT_L(0); PG8_BAR; PG8_MMA(1, 0, At, B0); PG8_MMA(1, 1, At, B1); PG8_BAR; PG8_SCHED;
        }
        if constexpr (ALIGN_EPI) { if (wr == 0) PG8_BAR; }
        if constexpr (!Epi::AFTER_DRAIN) { E(acc, cur, wr, wc, fr, fq, wid, lane, ui); }
        if (!has_next) break;
#pragma unroll
        for (int a = 0; a < 2; ++a)
#pragma unroll
            for (int b = 0; b < 2; ++b)
#pragma unroll
                for (int m = 0; m < 4; ++m)
#pragma unroll
                    for (int n = 0; n < 2; ++n) acc[a][b][m][n] = (f32x4){0.f, 0.f, 0.f, 0.f};
        cur = nxt; cA = nA; cB = nB; ++ui;
        if constexpr (ALIGN_EPI) { if (wr == 1) PG8_BAR; }
    }
    PG8_WAIT_V(0);
    if constexpr (!ALIGN_EPI) { if (wr == 0) PG8_BAR; }
    PG8_BAR;
    if constexpr (Epi::AFTER_DRAIN) { E(acc, cur, wr, wc, fr, fq, wid, lane, ui); }
#undef PG8_SA
#undef PG8_SB
#undef PG8_STAGE
#undef PG8_LDA
#undef PG8_LDB
#undef PG8_MMA
#undef PG8_WAIT_V
#undef PG8_WAIT_L
#undef PG8_BAR
#undef PG8_SCHED
#undef PG8_UA
#undef PG8_UB
}
}

namespace att {
typedef LAS const char* lds_cptr;
typedef short v4i16_t __attribute__((ext_vector_type(4)));
constexpr int STAGE = 65536, KV = 64;
__device__ __forceinline__ void glds16(const void* gsrc, unsigned lds_dst) { unsigned keep;
    asm volatile("s_mov_b32 %0, m0\n\ts_mov_b32 m0, %2\n\ts_nop 0\n\tglobal_load_lds_dwordx4 %1, off\n\ts_mov_b32 m0, %0" : "=&s"(keep) : "v"(gsrc), "s"(lds_dst) : "memory"); }
__device__ __forceinline__ v4i16_t vtr(lds_cptr p) { return __builtin_amdgcn_ds_read_tr16_b64_v4i16((LAS v4i16_t*)p); }
typedef float f32x2_t __attribute__((ext_vector_type(2))); typedef __bf16 bf16x2_t __attribute__((ext_vector_type(2)));
__device__ __forceinline__ unsigned cvtpk_s(float lo, float hi) { f32x2_t v = {lo, hi}; bf16x2_t b = __builtin_convertvector(v, bf16x2_t); return __builtin_bit_cast(unsigned, b); }
__device__ __forceinline__ float fadd_s(float a, float b) { float r; asm("v_add_f32_e32 %0, %1, %2" : "=v"(r) : "v"(a), "v"(b)); return r; }
#define ATT_WAIT_BAR() asm volatile("s_waitcnt vmcnt(0) lgkmcnt(0)\n\ts_barrier" ::: "memory")

template <int IDX> __device__ __forceinline__ void dma_piece(unsigned kvo, unsigned vvo, const char* kbn, const char* vbn, unsigned kdn, unsigned vdn) {
    unsigned keep, tv;
    if constexpr (IDX < 4) {
        constexpr int dl = (IDX & 1) * 16 + (IDX >> 1) * 256; const unsigned dst = kdn + (IDX & 1) * 0x400 + (IDX >> 1) * 0x4000;
        asm volatile("s_mov_b32 %0, m0\n\ts_mov_b32 m0, %3\n\tv_add_u32 %1, %4, %2\n\ts_nop 0\n\tglobal_load_lds_dwordx4 %1, %5\n\ts_mov_b32 m0, %0"
                     : "=&s"(keep), "=&v"(tv) : "v"(kvo), "s"(dst), "i"(dl), "s"(kbn) : "memory");
    } else {
        constexpr int dl = (IDX - 4) * 0x8000; const unsigned dst = vdn + (IDX - 4) * 0x400;
        asm volatile("s_mov_b32 %0, m0\n\ts_mov_b32 m0, %3\n\tv_add_u32 %1, %4, %2\n\ts_nop 0\n\tglobal_load_lds_dwordx4 %1, %5\n\ts_mov_b32 m0, %0"
                     : "=&s"(keep), "=&v"(tv) : "v"(vvo), "s"(dst), "i"(dl), "s"(vbn) : "memory");
    }
}
template <bool SHIFT> __device__ __forceinline__ void attn_item(int h, int qb, const bf16_t* Q, const bf16_t* Kt, const bf16_t* V, bf16_t* O, char* shm, float lam, float osc, const float* subg, float cshift, int wv) {
    int tid_ = (wv << 6) | lane_id(); asm volatile("" : "+v"(tid_));
    const int tid = tid_, lane = tid & 63, r32 = lane & 31, hi = lane >> 5;
    const int wid = __builtin_amdgcn_readfirstlane(tid >> 6), comp = wid >> 2, w = wid & 3;
    const int q0 = qb * 128;
    const unsigned lds0 = (unsigned)(uintptr_t)shm;
    const lds_cptr shm3 = (lds_cptr)shm;
    const unsigned kvo = (unsigned)(lane * D + wid * 16) * 2u;
    const unsigned vvo = (unsigned)((lane >> 2) * D + wid * 32 + (lane & 3) * 8) * 2u;
    const char* kbase = (const char*)(Kt + h * 256);
    const char* vbase = (const char*)(V + h * 256);
    const int NT = 2 * qb + 2, NTw = 2 * qb + 1 + (w >> 1);
#define ATT_DMA(t, st) do { const char* kb_ = kbase + (size_t)(t) * (KV * D * 2); const char* vb_ = vbase + (size_t)(t) * (KV * D * 2); \
        const unsigned kd_ = (unsigned)__builtin_amdgcn_readfirstlane(lds0 + (st) + wid * 2048), vd_ = (unsigned)__builtin_amdgcn_readfirstlane(lds0 + (st) + 32768 + wid * 4096); \
        unsigned keep_, tv_; \
        asm volatile("s_nop 4\n\ts_mov_b32 %0, m0\n\ts_mov_b32 m0, %4\n\ts_nop 0\n\t" \
                     "global_load_lds_dwordx4 %2, %6\n\tv_add_u32 %1, 16, %2\n\ts_add_u32 m0, m0, 0x400\n\ts_nop 0\n\t" \
                     "global_load_lds_dwordx4 %1, %6\n\tv_add_u32 %1, 0x100, %2\n\ts_add_u32 m0, m0, 0x3c00\n\ts_nop 0\n\t" \
                     "global_load_lds_dwordx4 %1, %6\n\tv_add_u32 %1, 0x110, %2\n\ts_add_u32 m0, m0, 0x400\n\ts_nop 0\n\t" \
                     "global_load_lds_dwordx4 %1, %6\n\ts_mov_b32 m0, %5\n\ts_nop 0\n\t" \
                     "global_load_lds_dwordx4 %3, %7\n\tv_add_u32 %1, 0x8000, %3\n\ts_add_u32 m0, m0, 0x400\n\ts_nop 0\n\t" \
                     "global_load_lds_dwordx4 %1, %7\n\tv_add_u32 %1, 0x8000, %1\n\ts_add_u32 m0, m0, 0x400\n\ts_nop 0\n\t" \
                     "global_load_lds_dwordx4 %1, %7\n\tv_add_u32 %1, 0x8000, %1\n\ts_add_u32 m0, m0, 0x400\n\ts_nop 0\n\t" \
                     "global_load_lds_dwordx4 %1, %7\n\ts_mov_b32 m0, %0" \
                     : "=&s"(keep_), "=&v"(tv_) : "v"(kvo), "v"(vvo), "s"(kd_), "s"(vd_), "s"(kb_), "s"(vb_) : "memory", "scc"); } while (0)
    ATT_DMA(0, 0);
    bf16x8 qr[8];
    { const bf16_t* qp = Q + (size_t)(q0 + 32 * w + r32) * D + h * 256 + comp * 128 + hi * 8;
#pragma unroll
      for (int ks = 0; ks < 8; ++ks) qr[ks] = *(const bf16x8*)(qp + ks * 16); }
    f32x16 o[8];
#pragma unroll
    for (int d0 = 0; d0 < 8; ++d0) o[d0] = f32x16{};
    float lsum = 0.f;
    const int koff = comp * 16384 + hi * 1024 + r32 * 16;
    const int voff = 32768 + ((r32 >> 4) & 1) * 32 + (r32 & 3) * 8 + (4 * hi + ((r32 & 15) >> 2)) * 64;
#define ATT_SB() __builtin_amdgcn_sched_barrier(0)
    for (int t = 0; t < NT; ++t) {
        const int st = (t & 1) * STAGE;
        ATT_WAIT_BAR();
        const bool has_next = (t + 1 < NT);
        const char* kbn = kbase + (size_t)(t + 1) * (KV * D * 2); const char* vbn = vbase + (size_t)(t + 1) * (KV * D * 2);
        const unsigned kdn = (unsigned)__builtin_amdgcn_readfirstlane(lds0 + (STAGE - st) + wid * 2048), vdn = (unsigned)__builtin_amdgcn_readfirstlane(lds0 + (STAGE - st) + 32768 + wid * 4096);
        if (t >= NTw) { if (has_next) ATT_DMA(t + 1, STAGE - st); }
        if (t < NTw) {
            const lds_cptr kb = shm3 + st + koff;
            const lds_cptr vb = shm3 + st + voff;
#define ATT_KFRAG(i_) (*(const LAS bf16x8*)(kb + ((i_) & 7) * 2048 + ((i_) >> 3) * 512))
#define ATT_VFRAG(dst, j_) do { const v4i16_t lo_ = vtr(vb + ((j_) & 7) * 4096 + ((j_) >> 3) * 1024), hh_ = vtr(vb + ((j_) & 7) * 4096 + ((j_) >> 3) * 1024 + 512); \
        dst = (bf16x8){lo_[0], lo_[1], lo_[2], lo_[3], hh_[0], hh_[1], hh_[2], hh_[3]}; } while (0)
            f32x16 s0, s1;
            u32x4 pw[4];
            bf16x8 kf[3], vf[3];
            float sa = 0.f, sb = 0.f;
            kf[0] = ATT_KFRAG(0); kf[1] = ATT_KFRAG(1);
#pragma unroll
            for (int i = 0; i < 16; ++i) {
                if (i + 2 < 16) kf[(i + 2) % 3] = ATT_KFRAG(i + 2);
                if ((i & 3) == 2) { if (has_next) { switch (i >> 2) {
                    case 0: dma_piece<0>(kvo, vvo, kbn, vbn, kdn, vdn); break; case 1: dma_piece<1>(kvo, vvo, kbn, vbn, kdn, vdn); break;
                    case 2: dma_piece<2>(kvo, vvo, kbn, vbn, kdn, vdn); break; default: dma_piece<3>(kvo, vvo, kbn, vbn, kdn, vdn); break; } } }
                if (i == 14) ATT_VFRAG(vf[0], 0);
                if (i == 15) ATT_VFRAG(vf[1], 1);
                if (i < 8) {
                    if (i == 0) s0 = __builtin_amdgcn_mfma_f32_32x32x16_bf16(kf[0], qr[0], f32x16{}, 0, 0, 0);
                    else s0 = __builtin_amdgcn_mfma_f32_32x32x16_bf16(kf[i % 3], qr[i], s0, 0, 0, 0);
                } else {
                    const int ks = i - 8;
                    if (ks == 0) s1 = __builtin_amdgcn_mfma_f32_32x32x16_bf16(kf[i % 3], qr[0], f32x16{}, 0, 0, 0);
                    else s1 = __builtin_amdgcn_mfma_f32_32x32x16_bf16(kf[i % 3], qr[ks], s1, 0, 0, 0);
                    s0[2 * ks] = __builtin_amdgcn_exp2f(SHIFT ? s0[2 * ks] - cshift : s0[2 * ks]); s0[2 * ks + 1] = __builtin_amdgcn_exp2f(SHIFT ? s0[2 * ks + 1] - cshift : s0[2 * ks + 1]);
                    if (ks >= 1) { sa = fadd_s(fadd_s(sa, s0[2 * ks - 2]), s0[2 * ks - 1]); pw[(ks - 1) >> 2][(ks - 1) & 3] = cvtpk_s(s0[2 * ks - 2], s0[2 * ks - 1]); }
                }
                ATT_SB();
            }
#pragma unroll
            for (int j = 0; j < 32; ++j) {
                if (j + 2 < 32) ATT_VFRAG(vf[(j + 2) % 3], j + 2);
                if ((j & 3) == 1 && j < 16) { if (has_next) { switch (4 + (j >> 2)) {
                    case 0: dma_piece<0>(kvo, vvo, kbn, vbn, kdn, vdn); break; case 1: dma_piece<1>(kvo, vvo, kbn, vbn, kdn, vdn); break;
                    case 2: dma_piece<2>(kvo, vvo, kbn, vbn, kdn, vdn); break; case 3: dma_piece<3>(kvo, vvo, kbn, vbn, kdn, vdn); break;
                    case 4: dma_piece<4>(kvo, vvo, kbn, vbn, kdn, vdn); break; case 5: dma_piece<5>(kvo, vvo, kbn, vbn, kdn, vdn); break;
                    case 6: dma_piece<6>(kvo, vvo, kbn, vbn, kdn, vdn); break; default: dma_piece<7>(kvo, vvo, kbn, vbn, kdn, vdn); break; } } }
                o[j & 7] = __builtin_amdgcn_mfma_f32_32x32x16_bf16(vf[j % 3], __builtin_bit_cast(bf16x8, pw[j >> 3]), o[j & 7], 0, 0, 0);
                if (j == 0) { sa = fadd_s(fadd_s(sa, s0[14]), s0[15]); pw[1][3] = cvtpk_s(s0[14], s0[15]); }
                if (j < 16) s1[j] = __builtin_amdgcn_exp2f(SHIFT ? s1[j] - cshift : s1[j]);
                if (j >= 1 && j < 17) sb = fadd_s(sb, s1[j - 1]);
                if (j >= 2 && j < 18 && !(j & 1)) pw[2 + ((j - 2) >> 3)][((j - 2) & 7) >> 1] = cvtpk_s(s1[j - 2], s1[j - 1]);
                ATT_SB();
            }
            lsum += sa + sb;
#undef ATT_KFRAG
#undef ATT_VFRAG
        }
    }
#undef ATT_SB
    const float l = xor32_sum(lsum);
    const float inv = 1.0f / l;
    ATT_WAIT_BAR();
    LAS f32x4* X = (LAS f32x4*)shm;
    if (comp == 1) {
        const float sc = inv * lam;
#pragma unroll
        for (int d0 = 0; d0 < 8; ++d0)
#pragma unroll
            for (int r4 = 0; r4 < 4; ++r4)
                { X[(w * 32 + d0 * 4 + r4) * 64 + lane] = (f32x4){o[d0][4 * r4] * sc, o[d0][4 * r4 + 1] * sc, o[d0][4 * r4 + 2] * sc, o[d0][4 * r4 + 3] * sc}; __builtin_amdgcn_sched_barrier(0); }
    }
    ATT_WAIT_BAR();
    if (comp == 0) {
        float ss = 0.f;
#pragma unroll
        for (int d0 = 0; d0 < 8; ++d0)
#pragma unroll
            for (int r4 = 0; r4 < 4; ++r4) {
                const f32x4 x = X[(w * 32 + d0 * 4 + r4) * 64 + lane];
#pragma unroll
                for (int i = 0; i < 4; ++i) { const float dd = o[d0][4 * r4 + i] * inv - x[i]; o[d0][4 * r4 + i] = dd; ss += dd * dd; }
                if (r4 == 3) __builtin_amdgcn_sched_barrier(0);
            }
        ss = xor32_sum(ss);
        const float rstd = __builtin_amdgcn_rsqf(ss * (1.0f / 256.0f) + NORM_EPS) * osc;
        bf16_t* orow = O + (size_t)(q0 + 32 * w + r32) * D + h * 256 + 4 * hi;
#pragma unroll
        for (int d0 = 0; d0 < 8; ++d0)
#pragma unroll
            for (int r4 = 0; r4 < 4; ++r4) {
                const int dv = 32 * d0 + 8 * r4;
                const f32x4 g4 = *(const f32x4*)(subg + dv + 4 * hi);
                u32x2 wv; wv.x = cvt_pk_bf16(o[d0][4 * r4] * rstd * g4[0], o[d0][4 * r4 + 1] * rstd * g4[1]); wv.y = cvt_pk_bf16(o[d0][4 * r4 + 2] * rstd * g4[2], o[d0][4 * r4 + 3] * rstd * g4[3]);
                *(u32x2*)(orow + dv) = wv;
                if (r4 == 3) __builtin_amdgcn_sched_barrier(0);
            }
    }
    ATT_WAIT_BAR();
#undef ATT_DMA
}
}

struct Args { const float* in[16]; float* out; unsigned char* ws; float invf[16]; };

__device__ __forceinline__ float wave_sum(float v) {
#pragma unroll
    for (int o = 1; o < 64; o <<= 1) v += __shfl_xor(v, o);
    return v;
}
__device__ __forceinline__ float wave_max(float v) {
#pragma unroll
    for (int o = 1; o < 64; o <<= 1) v = fmaxf(v, __shfl_xor(v, o));
    return v;
}
__device__ __forceinline__ unsigned f2bf(float f) { unsigned u = __builtin_bit_cast(unsigned, f); return (u + 0x7fffu + ((u >> 16) & 1u)) >> 16; }
__device__ __forceinline__ unsigned pk2(float lo, float hi) { return f2bf(lo) | (f2bf(hi) << 16); }

__device__ __forceinline__ void p0_transpose_item(const float* W, int K, int N, bf16_t* WT, int dest_row0, const float* gk, LAS float* scr, int k0, int n0, int lane) {
    float wv_[32];
    const float* wp = W + (size_t)(k0 + (lane >> 5)) * N + n0 + (lane & 31);
#pragma unroll
    for (int i = 0; i < 32; ++i) wv_[i] = wp[(size_t)(2 * i) * N];
    if (gk) {
#pragma unroll
        for (int i = 0; i < 32; ++i) wv_[i] *= gk[k0 + 2 * i + (lane >> 5)];
    }
#pragma unroll
    for (int i = 0; i < 32; ++i) scr[(2 * i + (lane >> 5)) * 33 + (lane & 31)] = wv_[i];
    asm volatile("s_waitcnt lgkmcnt(0)" ::: "memory");
    const int c = lane & 7;
#pragma unroll
    for (int j = 0; j < 4; ++j) { const int n = (lane >> 3) + 8 * j; const LAS float* s = scr + (8 * c) * 33 + n;
        u32x4 o; o.x = cvt_pk_bf16(s[0 * 33], s[1 * 33]); o.y = cvt_pk_bf16(s[2 * 33], s[3 * 33]); o.z = cvt_pk_bf16(s[4 * 33], s[5 * 33]); o.w = cvt_pk_bf16(s[6 * 33], s[7 * 33]);
        *(u32x4*)(WT + (size_t)(dest_row0 + n) * K + k0 + 8 * c) = o; }
    asm volatile("s_waitcnt lgkmcnt(0)" ::: "memory");
}

__device__ __forceinline__ void sincos_d(float angf, float& sn, float& cs) {
    const double a = (double)angf;
    const double n = rint(a * 0.63661977236758134308);
    double r = fma(-n, 1.57079632679489655800, a); r = fma(-n, 6.12323399573676603587e-17, r);
    const int q = ((int)n) & 3;
    const double r2 = r * r;
    const double sp = r * (1.0 + r2 * (-1.0 / 6 + r2 * (1.0 / 120 + r2 * (-1.0 / 5040 + r2 * (1.0 / 362880 + r2 * (-1.0 / 39916800 + r2 * (1.0 / 6227020800.0)))))));
    const double cp = 1.0 + r2 * (-0.5 + r2 * (1.0 / 24 + r2 * (-1.0 / 720 + r2 * (1.0 / 40320 + r2 * (-1.0 / 3628800 + r2 * (1.0 / 479001600.0 + r2 * (-1.0 / 87178291200.0)))))));
    const double s_ = (q == 0) ? sp : (q == 1) ? cp : (q == 2) ? -sp : -cp;
    const double c_ = (q == 0) ? cp : (q == 1) ? -sp : (q == 2) ? -cp : sp;
    sn = (float)s_; cs = (float)c_;
}

__device__ __forceinline__ void pooled_tile(const bf16_t* up, bf16_t* pooled, int pm, int g, int tid) {
    asm volatile("" : "+v"(tid));
    const int col = 256 * g + 8 * (tid & 31), wdw = 2 << g, t0 = 256 * pm + 16 * (tid >> 5);
    f32x4 sA = {0.f, 0.f, 0.f, 0.f}, sB = {0.f, 0.f, 0.f, 0.f};
    for (int i = 1; i <= wdw; ++i) { const int t = t0 - i; if (t >= 0) { f32x4 a, b; unpack8(*(const u32x4*)(up + (size_t)t * D + col), a, b); sA += a; sB += b; } }
#pragma unroll 4
    for (int tt = 0; tt < 16; ++tt) {
        const int t = t0 + tt;
        f32x4 ca, cb; unpack8(*(const u32x4*)(up + (size_t)t * D + col), ca, cb);
        sA += ca; sB += cb;
        if (t - wdw >= 0) { f32x4 a, b; unpack8(*(const u32x4*)(up + (size_t)(t - wdw) * D + col), a, b); sA -= a; sB -= b; }
        const float rc = 1.0f / (float)((t + 1 < wdw) ? (t + 1) : wdw);
        *(u32x4*)(pooled + (size_t)t * D + col) = pack8(sA * rc - ca, sB * rc - cb);
    }
}

__device__ __forceinline__ void fill_rstd(LAS float* xl, const float* ssq, const pg8::StaticOrder& S, int tid) {
    if (tid < 256) {
#pragma unroll
        for (int i = 0; i < 6; ++i) { pg8::Unit u; if (S.next(i, u)) { const int r = u.pm * 256 + tid;
            xl[XL_BYTES / 4 + i * 256 + tid] = __builtin_amdgcn_rsqf(((ssq[r] + ssq[M + r]) + (ssq[2 * M + r] + ssq[3 * M + r])) * (1.0f / 1024.0f) + NORM_EPS); } }
    }
    __syncthreads();
}
typedef const __attribute__((address_space(4))) Args* KArgsPtr;
#define KARGS(ap) KArgsPtr ap = (KArgsPtr)__builtin_amdgcn_kernarg_segment_ptr(); asm volatile("" : "+s"(ap))

__global__ void __launch_bounds__(NTHREADS, 2) fwd_megakernel(Args args_unused) {
    extern __shared__ __attribute__((aligned(16))) unsigned char lds_raw[];
    cg::grid_group grid = cg::this_grid();
    LAS unsigned char* lds = (LAS unsigned char*)lds_raw;
    LAS float* xl = (LAS float*)(lds + XL_OFF);
    const int wv = __builtin_amdgcn_readfirstlane(threadIdx.x >> 6);
    volatile LAS unsigned* bst = (volatile LAS unsigned*)(lds + LDS_BYTES - 16);
    if (wv == 0) { if (lane_id() == 0) { bst[0] = 0u; bst[1] = 0u; KARGS(ap0); (void)xb_add((unsigned*)(ap0->ws + WS_BAR) + XB_XCNT(xb_xcc_id()), 1u); } }
    __syncthreads();
#define GRID_BAR() do { KARGS(apb); grid_barrier((unsigned*)(apb->ws + WS_BAR), bst, wv); } while (0)
    if (gridDim.x == 0x7fffffffu) grid.sync();

    {
        KARGS(ap);
        unsigned char* ws = ap->ws;
        const int bx = blockIdx.x, G = gridDim.x, vcu = (bx % 8) * (G / 8) + bx / 8;
        int tid = (wv << 6) | lane_id(); asm volatile("" : "+v"(tid));
        const int lane = tid & 63, wave = wv;
        LAS float* scr = (LAS float*)(lds + wave * 16384);
        const int gw = vcu * NWAVES + wave, NGW = G * NWAVES;
        constexpr int I_IN = 16 * 192, I_OUT = 16 * 32, I_FF = 16 * 176, I_FO = 44 * 32, I_PL = 128, I_LAYER = I_IN + I_OUT + I_FF + I_FO + I_PL;
        for (int it = gw; it < DEPTH * I_LAYER; it += NGW) {
            const int L = it / I_LAYER; int r = it % I_LAYER;
            unsigned char* wl = ws + WS_W + (size_t)L * LAYER_W;
            if (r < I_IN) { const int kb = r / 192, nb = r % 192;
                p0_transpose_item(ap->in[2] + (size_t)L * D * NIN, D, NIN, (bf16_t*)(wl + OFF_WIN), 32 * nb, ap->in[1] + L * D, scr, 64 * kb, 32 * nb, lane); continue; }
            r -= I_IN;
            if (r < I_OUT) { const int kb = r / 32, nb = r % 32;
                p0_transpose_item(ap->in[12] + (size_t)L * D * D, D, D, (bf16_t*)(wl + OFF_WOUT), 32 * nb, nullptr, scr, 64 * kb, 32 * nb, lane); continue; }
            r -= I_OUT;
            if (r < I_FF) { const int kb = r / 176, nb = r % 176; const int n0 = 32 * nb, up = (n0 >= FF) ? 1 : 0, j = n0 - up * FF;
                p0_transpose_item(ap->in[14] + (size_t)L * D * NFF2, D, NFF2, (bf16_t*)(wl + OFF_WFF), 256 * (j / 128) + 128 * up + (j % 128), ap->in[13] + L * D, scr, 64 * kb, n0, lane); continue; }
            r -= I_FF;
            if (r < I_FO) { const int kb = r / 32, nb = r % 32;
                p0_transpose_item(ap->in[15] + (size_t)L * FF * D, FF, D, (bf16_t*)(wl + OFF_WFO), 32 * nb, nullptr, scr, 64 * kb, 32 * nb, lane); continue; }
            r -= I_FO;
            { const int gg = r / 32, rr = r % 32, kb = rr / 8, nb = rr % 8;
                p0_transpose_item(ap->in[10] + (size_t)L * 4 * 65536 + (size_t)gg * 65536, 256, 256, (bf16_t*)(wl + OFF_POOL) + (size_t)gg * 65536, 32 * nb, nullptr, scr, 64 * kb, 32 * nb, lane); }
        }
        const float* x_in = ap->in[0];
        bf16_t* xb = (bf16_t*)(ws + WS_XB); float* ssq = (float*)(ws + WS_SSQ);
        for (int m = gw; m < M; m += NGW) {
            const f32x4* xr = (const f32x4*)(x_in + (size_t)m * D) + lane;
            float s = 0.f;
#pragma unroll
            for (int j = 0; j < 4; ++j) { const f32x4 v = xr[64 * j]; s += (v[0] * v[0] + v[1] * v[1]) + (v[2] * v[2] + v[3] * v[3]);
                u32x2 w2; w2.x = cvt_pk_bf16(v[0], v[1]); w2.y = cvt_pk_bf16(v[2], v[3]); *((u32x2*)(xb + (size_t)m * D) + lane + 64 * j) = w2; }
            s = wave_sum(s);
            if (lane < 4) ssq[(size_t)lane * M + m] = (lane == 0) ? s : 0.f;
        }
        float* rcos = (float*)(ws + WS_COS); float* rsin = (float*)(ws + WS_SIN);
        for (int idx = vcu * NTHREADS + tid; idx < M * 16; idx += G * NTHREADS) {
            const int pos = idx >> 4, j = idx & 15;
            const float ang = (float)pos * ap->invf[j];
            float sn, cs; sincos_d(ang, sn, cs);
            rcos[idx] = cs; rsin[idx] = sn;
        }
    }
    GRID_BAR();

#pragma unroll 1
    for (int L = 0; L < DEPTH; ++L) {
        {
            KARGS(ap); unsigned char* ws = ap->ws; unsigned char* wl = ws + WS_W + (size_t)L * LAYER_W;
            pg8::Gemm g{(const bf16_t*)(ws + WS_XB), (const bf16_t*)(wl + OFF_WIN), D, D, D, 0};
            int bxl = blockIdx.x; asm volatile("" : "+s"(bxl)); pg8::StaticOrder S; S.init(M, NIN, GRID, bxl);
            pg8::EpiIn E{ws, ap->in[3] + L * 128, ap->in[4] + L * 128, xl};
            fill_rstd(xl, (const float*)(ws + WS_SSQ), S, (wv << 6) | lane_id());
            pg8::gemm_phase<pg8::EpiIn, true>(lds, g, S, E, wv);
        }
        GRID_BAR();
        {
            KARGS(ap); unsigned char* ws = ap->ws;
            int ln = lane_id(); asm volatile("" : "+v"(ln));
            const float lam_init = 0.8f - 0.6f * expf(-0.3f * (float)L);
            const float* lq1 = ap->in[5] + L * 128; const float* lk1 = ap->in[6] + L * 128; const float* lq2 = ap->in[7] + L * 128; const float* lk2 = ap->in[8] + L * 128;
            const float d1 = wave_sum_rl(lq1[ln] * lk1[ln] + lq1[ln + 64] * lk1[ln + 64]);
            const float d2 = wave_sum_rl(lq2[ln] * lk2[ln] + lq2[ln + 64] * lk2[ln + 64]);
            const float lam = expf(d1) - expf(d2) + lam_init;
            const float* gq = ap->in[3] + L * 128; const float* gk = ap->in[4] + L * 128;
            const float mq = wave_max_rl(fmaxf(fabsf(gq[ln]), fabsf(gq[ln + 64]))), mk = wave_max_rl(fmaxf(fabsf(gk[ln]), fabsf(gk[ln + 64])));
            const float cshift = 11.313708498984761f * 1.4426950408889634f * mq * mk;
            int bx = blockIdx.x; asm volatile("" : "+s"(bx)); const int vcu = (bx % 8) * (GRID / 8) + bx / 8;
            const int h = vcu >> 6, p = vcu & 63;
            const bf16_t* act0 = (const bf16_t*)(ws + WS_ACT);
            const bf16_t* Qb = act0 + ACT_ELEMS; const bf16_t* Kb = act0 + 2 * ACT_ELEMS; const bf16_t* Vb = act0 + 3 * ACT_ELEMS;
            bf16_t* attn = (bf16_t*)(ws + WS_ATTN);
            if (cshift <= 64.0f) {
                att::attn_item<false>(h, 127 - p, Qb, Kb, Vb, attn, (char*)lds_raw, lam, 1.0f - lam_init, ap->in[9] + L * 256, 0.0f, wv);
                att::attn_item<false>(h, p, Qb, Kb, Vb, attn, (char*)lds_raw, lam, 1.0f - lam_init, ap->in[9] + L * 256, 0.0f, wv);
            } else {
                att::attn_item<true>(h, 127 - p, Qb, Kb, Vb, attn, (char*)lds_raw, lam, 1.0f - lam_init, ap->in[9] + L * 256, cshift, wv);
                att::attn_item<true>(h, p, Qb, Kb, Vb, attn, (char*)lds_raw, lam, 1.0f - lam_init, ap->in[9] + L * 256, cshift, wv);
            }
        }
        GRID_BAR();
        {
            KARGS(ap); unsigned char* ws = ap->ws; unsigned char* wl = ws + WS_W + (size_t)L * LAYER_W;
            bf16_t* act0 = (bf16_t*)(ws + WS_ACT);
            int bxl = blockIdx.x; asm volatile("" : "+s"(bxl)); pg8::StaticOrder S; S.init(M, D, GRID, bxl);
            pg8::Unit u;
            (void)S.next(0, u); pooled_tile(act0, (bf16_t*)(ws + WS_POOLED), u.pm, u.pn, (wv << 6) | lane_id());
            asm volatile("s_waitcnt vmcnt(0)" ::: "memory");
            __syncthreads();
            pg8::Gemm g{(const bf16_t*)(ws + WS_POOLED), (const bf16_t*)(wl + OFF_POOL), D, 256, 256, 256};
            pg8::EpiMerge E{act0 + 4 * ACT_ELEMS, act0 + 5 * ACT_ELEMS, (const bf16_t*)(ws + WS_ATTN), ap->in[11] + L * D, (bf16_t*)(ws + WS_MERGED)};
            pg8::gemm_phase<pg8::EpiMerge, false>(lds, g, S, E, wv);
        }
        GRID_BAR();
        {
            KARGS(ap); unsigned char* ws = ap->ws; unsigned char* wl = ws + WS_W + (size_t)L * LAYER_W;
            pg8::Gemm g{(const bf16_t*)(ws + WS_MERGED), (const bf16_t*)(wl + OFF_WOUT), D, D, D, 0};
            int bxl = blockIdx.x; asm volatile("" : "+s"(bxl)); pg8::StaticOrder S; S.init(M, D, GRID, bxl);
            pg8::EpiRes E{(L == 0) ? ap->in[0] : (const float*)ap->out, ap->out, (bf16_t*)(ws + WS_XB), (float*)(ws + WS_SSQ), lds};
            pg8::gemm_phase<pg8::EpiRes, false>(lds, g, S, E, wv);
        }
        GRID_BAR();
        {
            KARGS(ap); unsigned char* ws = ap->ws; unsigned char* wl = ws + WS_W + (size_t)L * LAYER_W;
            pg8::Gemm g{(const bf16_t*)(ws + WS_XB), (const bf16_t*)(wl + OFF_WFF), D, D, D, 0};
            int bxl = blockIdx.x; asm volatile("" : "+s"(bxl)); pg8::StaticOrder S; S.init(M, NFF2, GRID, bxl);
            pg8::EpiSwiGLU E{(bf16_t*)(ws + WS_FFACT), xl};
            fill_rstd(xl, (const float*)(ws + WS_SSQ), S, (wv << 6) | lane_id());
            pg8::gemm_phase<pg8::EpiSwiGLU, true>(lds, g, S, E, wv);
        }
        GRID_BAR();
        {
            KARGS(ap); unsigned char* ws = ap->ws; unsigned char* wl = ws + WS_W + (size_t)L * LAYER_W;
            pg8::Gemm g{(const bf16_t*)(ws + WS_FFACT), (const bf16_t*)(wl + OFF_WFO), FF, FF, FF, 0};
            int bxl = blockIdx.x; asm volatile("" : "+s"(bxl)); pg8::StaticOrder S; S.init(M, D, GRID, bxl);
            pg8::EpiRes E{(const float*)ap->out, ap->out, (bf16_t*)(ws + WS_XB), (float*)(ws + WS_SSQ), lds};
            pg8::gemm_phase<pg8::EpiRes, false>(lds, g, S, E, wv);
        }
        if (L + 1 < DEPTH) GRID_BAR();
    }
}

extern "C" void kernel_launch(void* const* d_in, const int* in_sizes, int n_in, void* d_out, int out_size, void* d_ws, size_t ws_size, hipStream_t stream) {
    static int ready = 0;
    if (ready == 0) {
        if (n_in != 16 || in_sizes[0] != M * D || out_size != M * D || ws_size < WS_END) {
            fprintf(stderr, "kernel_launch: unexpected shapes (n_in %d, in0 %d, out %d, ws %zu < %zu); nothing launched\n", n_in, n_in > 0 ? in_sizes[0] : -1, out_size, ws_size, (size_t)WS_END); ready = -1; return; }
        if (hipFuncSetAttribute((const void*)fwd_megakernel, hipFuncAttributeMaxDynamicSharedMemorySize, LDS_BYTES) != hipSuccess) { fprintf(stderr, "kernel_launch: hipFuncSetAttribute failed\n"); ready = -1; return; }
        int dev = 0, cus = 0, per_cu = 0;
        (void)hipGetDevice(&dev); (void)hipDeviceGetAttribute(&cus, hipDeviceAttributeMultiprocessorCount, dev);
        (void)hipOccupancyMaxActiveBlocksPerMultiprocessor(&per_cu, (const void*)fwd_megakernel, NTHREADS, LDS_BYTES);
        if (cus * per_cu < GRID) fprintf(stderr, "kernel_launch: note: %d CUs x %d blocks/CU < grid %d\n", cus, per_cu, GRID);
        (void)hipGetLastError();
        ready = 1;
    }
    if (ready < 0) return;
    if (hipMemsetAsync((char*)d_ws + WS_BAR, 0, WS_BAR_BYTES, stream) != hipSuccess) { fprintf(stderr, "kernel_launch: hipMemsetAsync failed\n"); return; }
    Args a{};
    for (int i = 0; i < 16; ++i) a.in[i] = (const float*)d_in[i];
    a.out = (float*)d_out; a.ws = (unsigned char*)d_ws;
    for (int j = 0; j < 16; ++j) a.invf[j] = (float)pow(500000.0, -(double)j / 16.0);
    void* kargs[] = {&a};
    hipError_t e = hipLaunchCooperativeKernel((const void*)fwd_megakernel, dim3(GRID), dim3(NTHREADS), kargs, LDS_BYTES, stream);
    if (e != hipSuccess) fprintf(stderr, "kernel_launch: cooperative launch failed: %s\n", hipGetErrorString(e));
}
```

```cpp
#include <hip/hip_runtime.h>
#include <hip/hip_cooperative_groups.h>
#include <cstdio>
#include <cstdint>
#include <cmath>
namespace cg = cooperative_groups;

#define LAS __attribute__((address_space(3)))
typedef unsigned short bf16_t;
typedef short bf16x8 __attribute__((ext_vector_type(8)));
typedef float f32x4 __attribute__((ext_vector_type(4)));
typedef float f32x16 __attribute__((ext_vector_type(16)));
typedef unsigned u32x4 __attribute__((ext_vector_type(4)));
typedef unsigned u32x2 __attribute__((ext_vector_type(2)));

constexpr int M = 16384, D = 1024, NIN = 6144, FF = 2816, NFF2 = 5632, DEPTH = 4;
constexpr float NORM_EPS = 1e-6f;
constexpr float QSC = 0.08838834764831845f * 1.4426950408889634f;
constexpr size_t ACT_ELEMS = (size_t)M * D;

constexpr size_t MiB = 1u << 20;
constexpr size_t SZ_WIN = (size_t)NIN * D * 2, SZ_WOUT = (size_t)D * D * 2, SZ_WFF = (size_t)NFF2 * D * 2, SZ_WFO = (size_t)D * FF * 2, SZ_POOL = 4 * 256 * 256 * 2;
constexpr size_t OFF_WIN = 0, OFF_WOUT = OFF_WIN + SZ_WIN, OFF_WFF = OFF_WOUT + SZ_WOUT, OFF_WFO = OFF_WFF + SZ_WFF, OFF_POOL = OFF_WFO + SZ_WFO, LAYER_W = OFF_POOL + SZ_POOL;
static_assert(LAYER_W == 31 * MiB, "weights per layer");
constexpr size_t WS_W = 0;
constexpr size_t WS_ACT = 124 * MiB;
constexpr size_t WS_ATTN = WS_ACT + 6 * 32 * MiB;
constexpr size_t WS_XB = WS_ATTN + 32 * MiB;
constexpr size_t WS_SSQ = WS_XB + 32 * MiB;
constexpr size_t WS_COS = WS_SSQ + 4 * M * 4;
constexpr size_t WS_SIN = WS_COS + (size_t)M * 16 * 4;
constexpr size_t WS_BAR = WS_SIN + (size_t)M * 16 * 4;
constexpr size_t WS_BAR_BYTES = 16384;
constexpr size_t WS_END = WS_BAR + WS_BAR_BYTES;
constexpr size_t WS_FFACT = WS_ACT;
constexpr size_t WS_MERGED = WS_ACT + 32 * MiB;
constexpr size_t WS_POOLED = WS_ACT + 64 * MiB;
static_assert((size_t)M * FF * 2 <= 96 * MiB, "ffn activation overlay");

constexpr int RING_BYTES = 131072, XL_OFF = RING_BYTES, XL_BYTES = 8192, LDS_BYTES = 147456;
constexpr int NWAVES = 8, NTHREADS = 512, GRID = 256;

__device__ __forceinline__ unsigned cvt_pk_bf16(float lo, float hi) { unsigned r; asm volatile("v_cvt_pk_bf16_f32 %0, %1, %2" : "=v"(r) : "v"(lo), "v"(hi)); return r; }
__device__ __forceinline__ float bf_lo(unsigned w) { return __uint_as_float(w << 16); }
__device__ __forceinline__ float bf_hi(unsigned w) { return __uint_as_float(w & 0xffff0000u); }
__device__ __forceinline__ u32x4 pack8(const f32x4 a, const f32x4 b) { u32x4 w; w.x = cvt_pk_bf16(a[0], a[1]); w.y = cvt_pk_bf16(a[2], a[3]); w.z = cvt_pk_bf16(b[0], b[1]); w.w = cvt_pk_bf16(b[2], b[3]); return w; }
__device__ __forceinline__ void unpack8(const u32x4 w, f32x4& a, f32x4& b) { a = (f32x4){bf_lo(w.x), bf_hi(w.x), bf_lo(w.y), bf_hi(w.y)}; b = (f32x4){bf_lo(w.z), bf_hi(w.z), bf_lo(w.w), bf_hi(w.w)}; }
__device__ __forceinline__ float sigmoidf_(float x) { return __builtin_amdgcn_rcpf(1.0f + __builtin_amdgcn_exp2f(-1.4426950408889634f * x)); }
__device__ __forceinline__ int lane_id() { int r; asm volatile("v_mbcnt_lo_u32_b32 %0, -1, 0\n\tv_mbcnt_hi_u32_b32 %0, -1, %0" : "=v"(r)); return r; }
#define XB_TMO      128
#define XB_XCNT(j)  (256  + 64 * (j))
#define XB_XSUB(j)  (1280 + 64 * (j))
#define XB_XGEN(j)  (2304 + 64 * (j))
#define XB_TOP      3328
#define XB_TOPGEN   3392
#define XCD_BAR_WORDS 3456
#define XB_SPIN_CAP (1u << 22)
__device__ __forceinline__ unsigned xb_ld(unsigned* p)              { return __hip_atomic_load(p, __ATOMIC_RELAXED, __HIP_MEMORY_SCOPE_AGENT); }
__device__ __forceinline__ unsigned xb_add(unsigned* p, unsigned v) { return __hip_atomic_fetch_add(p, v, __ATOMIC_RELAXED, __HIP_MEMORY_SCOPE_AGENT); }
__device__ __forceinline__ unsigned xb_xcc_id() { return (unsigned)__builtin_amdgcn_s_getreg((3 << 11) | 20) & 0xFu; }
#define XB_SPIN(cond, bar) do { unsigned _sp = 0; while (cond) { __builtin_amdgcn_s_sleep(1); \
    if ((++_sp & 255u) == 0u) { if (xb_ld(&(bar)[XB_TMO])) break; if (_sp > XB_SPIN_CAP) { atomicAdd(&(bar)[XB_TMO], 1u); break; } } } } while (0)
__device__ __forceinline__ void xcd_barrier_complete(unsigned* bar, unsigned x, unsigned& nloc, unsigned& nx) {
    const unsigned G = gridDim.x;
    unsigned sum, cnt, mine, sp = 0u;
    for (;;) {
        sum = 0u; cnt = 0u; mine = 0u;
#pragma unroll
        for (unsigned j = 0; j < 16; ++j) { const unsigned c = xb_ld(&bar[XB_XCNT(j)]); sum += c; cnt += (c > 0u) ? 1u : 0u; mine = (j == x) ? c : mine; }
        if (sum == G) break;
        __builtin_amdgcn_s_sleep(1);
        if ((++sp & 255u) == 0u) { if (xb_ld(&bar[XB_TMO])) break; if (sp > XB_SPIN_CAP) { atomicAdd(&bar[XB_TMO], 1u); break; } }
    }
    nloc = mine > 0u ? mine : 1u; nx = cnt > 0u ? cnt : 1u;
}
__device__ __forceinline__ void grid_barrier(unsigned* bar, volatile LAS unsigned* st, int wv) {
    asm volatile("s_waitcnt vmcnt(0) lgkmcnt(0)" ::: "memory");
    __syncthreads();
    if (wv == 0) {
        if (lane_id() == 0) {
            const unsigned x = xb_xcc_id();
            unsigned nloc = st[0], nx = st[1];
            if (nloc == 0u) { xcd_barrier_complete(bar, x, nloc, nx); st[0] = nloc; st[1] = nx; }
            const unsigned old = xb_add(&bar[XB_XSUB(x)], 1u);
            const unsigned gen = old / nloc;
            if (old + 1u == (gen + 1u) * nloc) {
                __builtin_amdgcn_fence(__ATOMIC_RELEASE, "agent");
                asm volatile("s_waitcnt vmcnt(0)" ::: "memory");
                const unsigned og = xb_add(&bar[XB_TOP], 1u);
                const unsigned tg = og / nx;
                if (og + 1u == (tg + 1u) * nx) xb_add(&bar[XB_TOPGEN], 1u);
                else XB_SPIN(xb_ld(&bar[XB_TOPGEN]) == tg, bar);
                __builtin_amdgcn_fence(__ATOMIC_ACQUIRE, "agent");
                xb_add(&bar[XB_XGEN(x)], 1u);
                asm volatile("s_waitcnt vmcnt(0)" ::: "memory");
            } else {
                XB_SPIN(xb_ld(&bar[XB_XGEN(x)]) == gen, bar);
                __builtin_amdgcn_fence(__ATOMIC_ACQUIRE, "agent");
                asm volatile("s_waitcnt vmcnt(0)" ::: "memory");
            }
        }
    }
    __syncthreads();
}
__device__ __forceinline__ float xor32_sum(float v) { auto rr = __builtin_amdgcn_permlane32_swap(__float_as_uint(v), __float_as_uint(v), false, false); return __uint_as_float(rr[0]) + __uint_as_float(rr[1]); }
__device__ __forceinline__ float xor32_get(float v, int hi) { auto rr = __builtin_amdgcn_permlane32_swap(__float_as_uint(v), __float_as_uint(v), false, false); return hi ? __uint_as_float(rr[0]) : __uint_as_float(rr[1]); }
__device__ __forceinline__ float xor16_sum(float v) { return v + __uint_as_float((unsigned)__builtin_amdgcn_ds_swizzle((int)__float_as_uint(v), 0x401F)); }
__device__ __forceinline__ float wave_sum_rl(float v) { float s = 0.f;
#pragma unroll
    for (int i = 0; i < 64; ++i) s += __uint_as_float((unsigned)__builtin_amdgcn_readlane((int)__float_as_uint(v), i));
    return s; }
__device__ __forceinline__ float wave_max_rl(float v) { float s = 0.f;
#pragma unroll
    for (int i = 0; i < 64; ++i) s = fmaxf(s, __uint_as_float((unsigned)__builtin_amdgcn_readlane((int)__float_as_uint(v), i)));
    return s; }
#define LDS_BAR() do { asm volatile("s_waitcnt lgkmcnt(0)" ::: "memory"); __builtin_amdgcn_s_barrier(); asm volatile("" ::: "memory"); } while (0)

namespace pg8 {
constexpr int BM = 256, BK = 64, HALF = 128, HTB = HALF * BK * 2, NXCD = 8, WGM = 8;
__device__ __forceinline__ int lds_byte(int r, int c) { const int st = (r >> 4) * 2 + (c >> 5), rr = r & 15, cc = c & 31, ob = rr * 64 + cc * 2; return st * 1024 + (ob ^ (((ob >> 9) & 1) << 5)); }
__device__ __forceinline__ void stage_rc(int b, int& R, int& C) { const int st = b / 1024, sb = b % 1024, swz = sb ^ (((sb >> 9) & 1) << 5); R = (st >> 1) * 16 + swz / 64; C = (st & 1) * 32 + (swz % 64) / 2; }
__device__ __forceinline__ int perm32(int rho) { const int n = rho >> 4, i = rho & 15; return 8 * (i >> 2) + 4 * n + (i & 3); }

struct Unit { int pm, pn; };
struct Gemm { const bf16_t* A; const bf16_t* Bt; int lda, ldb, K, a_cpn; };

struct StaticOrder {
    int nM, nN, nwg, G, c;
    __device__ void init(int M_, int N_, int G_, int c_) { nM = M_ / BM; nN = N_ / BM; nwg = nM * nN; G = G_; c = c_; }
    __device__ bool next(int i, Unit& u) const {
        const long L = (long)i * G + c; if (L >= nwg) return false;
        int wgid = (int)L; { const int q = nwg / NXCD, r = nwg % NXCD, xcd = wgid % NXCD, off = wgid / NXCD; wgid = (xcd < r ? xcd * (q + 1) : r * (q + 1) + (xcd - r) * q) + off; }
        const int nig = WGM * nN, gid = wgid / nig, fm = gid * WGM, gsz = (nM - fm) < WGM ? (nM - fm) : WGM;
        u.pm = fm + ((wgid % nig) % gsz); u.pn = (wgid % nig) / gsz; return true;
    }
};


struct EpiIn {
    static constexpr bool PERM = true, AFTER_DRAIN = false;
    unsigned char* ws; const float* gq; const float* gk; LAS float* xl;
    __device__ __forceinline__ void operator()(f32x4 (&acc)[2][2][4][2], const Unit& u, int wr, int wc, int fr, int fq, int wid, int lane, int ui) const {
        bf16_t* out0 = (bf16_t*)(ws + WS_ACT); const float* rcos = (const float*)(ws + WS_COS); const float* rsin = (const float*)(ws + WS_SIN);
        const LAS float* rsl = xl + XL_BYTES / 4 + ui * 256;
        const int kind = u.pn >> 2, cb = (u.pn & 3) * 256;
        bf16_t* dst = out0 + (size_t)kind * ACT_ELEMS;
        const int row0 = u.pm * BM + wr * 64 + fr, colw = wc * 32 + 8 * fq;
#pragma unroll
        for (int ai = 0; ai < 2; ++ai)
#pragma unroll
            for (int m = 0; m < 4; ++m) {
                const float rs = rsl[ai * HALF + wr * 64 + m * 16 + fr];
#pragma unroll
                for (int bj = 0; bj < 2; ++bj)
#pragma unroll
                    for (int n = 0; n < 2; ++n) acc[ai][bj][m][n] *= rs;
                if (m & 1) __builtin_amdgcn_sched_barrier(0);
            }
        if (kind == 1 || kind == 2) {
            const float* g = (kind == 1) ? gq : gk;
#pragma unroll
            for (int ai = 0; ai < 2; ++ai)
#pragma unroll
                for (int m = 0; m < 4; ++m)
#pragma unroll
                    for (int bj = 0; bj < 2; ++bj) {
                        const f32x4 a = acc[ai][bj][m][0], b = acc[ai][bj][m][1];
                        float ss = (a[0] * a[0] + a[1] * a[1]) + (a[2] * a[2] + a[3] * a[3]) + (b[0] * b[0] + b[1] * b[1]) + (b[2] * b[2] + b[3] * b[3]);
                        ss = xor32_sum(xor16_sum(ss));
                        if (fq == 0) xl[((ai * HALF + wr * 64 + m * 16 + fr) * 2 + bj) * 4 + wc] = ss;
                    }
            LDS_BAR();
            const f32x4 g0 = *(const f32x4*)(g + colw), g1 = *(const f32x4*)(g + colw + 4);
            const float osc = (kind == 1) ? QSC : 1.0f;
            const float sgn = (fq < 2) ? -1.0f : 1.0f;
#pragma unroll
            for (int ai = 0; ai < 2; ++ai)
#pragma unroll
                for (int m = 0; m < 4; ++m) {
                    const int rt = ai * HALF + wr * 64 + m * 16 + fr, r = u.pm * BM + rt;
                    f32x4 c0, c1, s0, s1;
                    if (wc == 0) { const int j0 = 8 * (fq & 1); c0 = *(const f32x4*)(rcos + (size_t)r * 16 + j0); c1 = *(const f32x4*)(rcos + (size_t)r * 16 + j0 + 4);
                                   s0 = *(const f32x4*)(rsin + (size_t)r * 16 + j0); s1 = *(const f32x4*)(rsin + (size_t)r * 16 + j0 + 4); }
#pragma unroll
                    for (int bj = 0; bj < 2; ++bj) {
                        const f32x4 t4 = *(const LAS f32x4*)(xl + (rt * 2 + bj) * 4);
                        const float rn = __builtin_amdgcn_rsqf(((t4[0] + t4[1]) + (t4[2] + t4[3])) * (1.0f / 128.0f) + NORM_EPS);
                        f32x4 v0 = acc[ai][bj][m][0] * rn * g0, v1 = acc[ai][bj][m][1] * rn * g1;
                        if (wc == 0) {
                            f32x4 p0, p1;
#pragma unroll
                            for (int i = 0; i < 4; ++i) { p0[i] = xor32_get(v0[i], fq >> 1); p1[i] = xor32_get(v1[i], fq >> 1); }
                            v0 = v0 * c0 + (p0 * s0) * sgn; v1 = v1 * c1 + (p1 * s1) * sgn;
                        }
                        v0 *= osc; v1 *= osc;
                        *(u32x4*)(dst + (size_t)r * D + cb + bj * HALF + colw) = pack8(v0, v1);
                    }
                    __builtin_amdgcn_sched_barrier(0);
                }
        } else {
            const bool sg = kind >= 4;
#pragma unroll
            for (int ai = 0; ai < 2; ++ai)
#pragma unroll
                for (int m = 0; m < 4; ++m) {
                    const int r = row0 + ai * HALF + m * 16;
#pragma unroll
                    for (int bj = 0; bj < 2; ++bj) {
                        f32x4 v0 = acc[ai][bj][m][0], v1 = acc[ai][bj][m][1];
                        if (sg) {
#pragma unroll
                            for (int i = 0; i < 4; ++i) { v0[i] = sigmoidf_(v0[i]); v1[i] = sigmoidf_(v1[i]); }
                        }
                        *(u32x4*)(dst + (size_t)r * D + cb + bj * HALF + colw) = pack8(v0, v1);
                    }
                }
        }
    }
};

struct EpiSwiGLU {
    static constexpr bool PERM = true, AFTER_DRAIN = false;
    bf16_t* act; LAS float* xl;
    __device__ __forceinline__ void operator()(f32x4 (&acc)[2][2][4][2], const Unit& u, int wr, int wc, int fr, int fq, int wid, int lane, int ui) const {
        const int row0 = u.pm * BM + wr * 64 + fr, col = u.pn * HALF + wc * 32 + 8 * fq;
#pragma unroll
        for (int ai = 0; ai < 2; ++ai)
#pragma unroll
            for (int m = 0; m < 4; ++m) {
                const int r = row0 + ai * HALF + m * 16;
                const float rs = xl[XL_BYTES / 4 + ui * 256 + ai * HALF + wr * 64 + m * 16 + fr];
                f32x4 o[2];
#pragma unroll
                for (int n = 0; n < 2; ++n) {
                    const f32x4 gt = acc[ai][0][m][n] * rs, up = acc[ai][1][m][n] * rs;
#pragma unroll
                    for (int i = 0; i < 4; ++i) o[n][i] = gt[i] * sigmoidf_(gt[i]) * up[i];
                }
                *(u32x4*)(act + (size_t)r * FF + col) = pack8(o[0], o[1]);
            }
    }
};

struct EpiMerge {
    static constexpr bool PERM = true, AFTER_DRAIN = true;
    const bf16_t* sga; const bf16_t* sgb; const bf16_t* o0; const bf16_t* o1; const float* pscale; const float* subg; bf16_t* merged; float osc; LAS float* xl;
    __device__ __forceinline__ void operator()(f32x4 (&acc)[2][2][4][2], const Unit& u, int wr, int wc, int fr, int fq, int wid, int lane, int ui) const {
        const int row0 = u.pm * BM + wr * 64 + fr;
#pragma unroll
        for (int ai = 0; ai < 2; ++ai)
#pragma unroll
            for (int m = 0; m < 4; ++m) {
                float ss = 0.f;
#pragma unroll
                for (int bj = 0; bj < 2; ++bj) {
                    const size_t off = (size_t)(row0 + ai * HALF + m * 16) * D + u.pn * BM + bj * HALF + wc * 32 + 8 * fq;
                    f32x4 a0, a1, b0, b1; unpack8(*(const u32x4*)(o0 + off), a0, a1); unpack8(*(const u32x4*)(o1 + off), b0, b1);
                    const f32x4 d0 = a0 - b0, d1 = a1 - b1;
                    ss += (d0[0] * d0[0] + d0[1] * d0[1]) + (d0[2] * d0[2] + d0[3] * d0[3]) + (d1[0] * d1[0] + d1[1] * d1[1]) + (d1[2] * d1[2] + d1[3] * d1[3]);
                }
                ss = xor32_sum(xor16_sum(ss));
                if (fq == 0) xl[(ai * HALF + wr * 64 + m * 16 + fr) * 4 + wc] = ss;
            }
        LDS_BAR();
#pragma unroll
        for (int bj = 0; bj < 2; ++bj) {
            const int col = u.pn * BM + bj * HALF + wc * 32 + 8 * fq;
            const f32x4 ps0 = *(const f32x4*)(pscale + col), ps1 = *(const f32x4*)(pscale + col + 4);
            const f32x4 g0 = *(const f32x4*)(subg + (col & 255)), g1 = *(const f32x4*)(subg + (col & 255) + 4);
#pragma unroll
            for (int ai = 0; ai < 2; ++ai)
#pragma unroll
                for (int m = 0; m < 4; ++m) {
                    const int rt = ai * HALF + wr * 64 + m * 16 + fr;
                    const f32x4 t4 = *(const LAS f32x4*)(xl + rt * 4);
                    const float rn = __builtin_amdgcn_rsqf(((t4[0] + t4[1]) + (t4[2] + t4[3])) * (1.0f / 256.0f) + NORM_EPS) * osc;
                    const size_t off = (size_t)(u.pm * BM + rt) * D + col;
                    const u32x4 wa = *(const u32x4*)(sga + off), wb = *(const u32x4*)(sgb + off), w0 = *(const u32x4*)(o0 + off), w1 = *(const u32x4*)(o1 + off);
                    f32x4 a0, a1, b0, b1, x0, x1, y0, y1; unpack8(wa, a0, a1); unpack8(wb, b0, b1); unpack8(w0, x0, x1); unpack8(w1, y0, y1);
                    const f32x4 t0 = (x0 - y0) * g0 * rn, t1 = (x1 - y1) * g1 * rn;
                    const f32x4 r0 = a0 * (acc[ai][bj][m][0] * ps0) + b0 * t0, r1 = a1 * (acc[ai][bj][m][1] * ps1) + b1 * t1;
                    *(u32x4*)(merged + off) = pack8(r0, r1);
                }
        }
        LDS_BAR();
    }
};

__device__ __forceinline__ float swz_sum32(float v) {
    v += __uint_as_float((unsigned)__builtin_amdgcn_ds_swizzle((int)__float_as_uint(v), 0x041F));
    v += __uint_as_float((unsigned)__builtin_amdgcn_ds_swizzle((int)__float_as_uint(v), 0x081F));
    v += __uint_as_float((unsigned)__builtin_amdgcn_ds_swizzle((int)__float_as_uint(v), 0x101F));
    v += __uint_as_float((unsigned)__builtin_amdgcn_ds_swizzle((int)__float_as_uint(v), 0x201F));
    v += __uint_as_float((unsigned)__builtin_amdgcn_ds_swizzle((int)__float_as_uint(v), 0x401F));
    return v;
}
struct EpiRes {
    static constexpr bool PERM = false, AFTER_DRAIN = true;
    const float* res; float* out; bf16_t* xb; float* ssq; LAS unsigned char* lds;
    __device__ __forceinline__ void operator()(f32x4 (&acc)[2][2][4][2], const Unit& u, int wr, int wc, int fr, int fq, int wid, int lane, int ui) const {
        constexpr int RS = 1040;
#pragma unroll
        for (int ai = 0; ai < 2; ++ai) {
#pragma unroll
            for (int m = 0; m < 4; ++m)
#pragma unroll
                for (int bj = 0; bj < 2; ++bj)
#pragma unroll
                    for (int n = 0; n < 2; ++n)
                        *(LAS f32x4*)(lds + (wr * 64 + m * 16 + fr) * RS + (bj * HALF + wc * 32 + n * 16 + 4 * fq) * 4) = acc[ai][bj][m][n];
            LDS_BAR();
#pragma unroll 1
            for (int c = 0; c < 2; ++c) {
                f32x4 rv[8];
#pragma unroll
                for (int rr = 0; rr < 8; ++rr) { const size_t grow = (size_t)(u.pm * BM + ai * HALF + wid * 16 + c * 8 + rr); rv[rr] = *((const f32x4*)(res + grow * D + u.pn * BM) + lane); }
#pragma unroll
                for (int rr = 0; rr < 8; ++rr) {
                    const int rl = wid * 16 + c * 8 + rr; const size_t grow = (size_t)(u.pm * BM + ai * HALF + rl);
                    const f32x4 v = rv[rr] + *(const LAS f32x4*)(lds + rl * RS + lane * 16);
                    *((f32x4*)(out + grow * D + u.pn * BM) + lane) = v;
                    u32x2 w; w.x = cvt_pk_bf16(v[0], v[1]); w.y = cvt_pk_bf16(v[2], v[3]);
                    *((u32x2*)(xb + grow * D + u.pn * BM) + lane) = w;
                    float ss = (v[0] * v[0] + v[1] * v[1]) + (v[2] * v[2] + v[3] * v[3]);
                    ss = xor32_sum(swz_sum32(ss));
                    if (lane == 0) ssq[(size_t)u.pn * M + grow] = ss;
                }
            }
            LDS_BAR();
        }
    }
};

template <class Epi, bool ALIGN_EPI>
__device__ __forceinline__ void gemm_phase(LAS unsigned char* lds, const Gemm g, const StaticOrder& S, const Epi& E, int wv) {
    int tid_ = (wv << 6) | lane_id(); asm volatile("" : "+v"(tid_));
    const int tid = tid_, wid = __builtin_amdgcn_readfirstlane(tid >> 6), lane = tid & 63, wr = wid >> 2, wc = wid & 3, fr = lane & 15, fq = lane >> 4;
    const int K = g.K, nt = K / BK;
    unsigned voffA[2], voffB[2];
#pragma unroll
    for (int i = 0; i < 2; ++i) { int R, C; stage_rc(tid * 16 + i * 8192, R, C); const int Rb = Epi::PERM ? ((R & ~31) + perm32(R & 31)) : R;
        voffA[i] = (unsigned)(R * g.lda + C) * 2u; voffB[i] = (unsigned)(Rb * g.ldb + C) * 2u; }
    const size_t kstep = (size_t)(BK * 2);
    const size_t hstepA = (size_t)HALF * g.lda * 2, hstepB = (size_t)HALF * g.ldb * 2;
    const unsigned ldsw = (unsigned)wid * 1024u;
    const int aoff = lds_byte(wr * 64 + fr, fq * 8), boff = lds_byte(wc * 32 + fr, fq * 8);
#define PG8_SA(b, h) (((b) * 2 + (h)) * HTB)
#define PG8_SB(b, h) ((4 + (b) * 2 + (h)) * HTB)
#define PG8_STAGE(bufoff, gbase, voff) do { _Pragma("unroll") for (int _i = 0; _i < 2; ++_i) \
        __builtin_amdgcn_global_load_lds((const unsigned*)((const char*)(gbase) + (voff)[_i]), (LAS unsigned*)(lds + (bufoff) + ldsw + _i * 8192), 16, 0, 0); } while (0)
#define PG8_LDA(dst, b, h) do { _Pragma("unroll") for (int m = 0; m < 4; ++m) _Pragma("unroll") for (int k = 0; k < 2; ++k) dst[m][k] = *(const LAS bf16x8*)(lds + PG8_SA(b, h) + aoff + m * 2048 + k * 1024); } while (0)
#define PG8_LDB(dst, b, h) do { _Pragma("unroll") for (int n = 0; n < 2; ++n) _Pragma("unroll") for (int k = 0; k < 2; ++k) dst[n][k] = *(const LAS bf16x8*)(lds + PG8_SB(b, h) + boff + n * 2048 + k * 1024); } while (0)
#define PG8_MMA(ai, bj, At, Bt) do { __builtin_amdgcn_s_setprio(1); _Pragma("unroll") for (int m = 0; m < 4; ++m) _Pragma("unroll") for (int n = 0; n < 2; ++n) _Pragma("unroll") for (int k = 0; k < 2; ++k) \
        acc[ai][bj][m][n] = __builtin_amdgcn_mfma_f32_16x16x32_bf16(Bt[n][k], At[m][k], acc[ai][bj][m][n], 0, 0, 0); __builtin_amdgcn_s_setprio(0); } while (0)
#define PG8_WAIT_V(n) asm volatile("s_waitcnt vmcnt(" #n ")" ::: "memory")
#define PG8_WAIT_L(n) asm volatile("s_waitcnt lgkmcnt(" #n ")" ::: "memory")
#define PG8_BAR __builtin_amdgcn_s_barrier()
#define PG8_SCHED __builtin_amdgcn_sched_barrier(0)
#define PG8_UA(u_) ((const char*)g.A + ((size_t)(u_).pm * BM * g.lda + (size_t)(u_).pn * g.a_cpn) * 2)
#define PG8_UB(u_) ((const char*)g.Bt + (size_t)(u_).pn * BM * g.ldb * 2)
    Unit cur, nxt; int ui = 0;
    (void)S.next(0, cur);
    f32x4 acc[2][2][4][2];
#pragma unroll
    for (int a = 0; a < 2; ++a)
#pragma unroll
        for (int b = 0; b < 2; ++b)
#pragma unroll
            for (int m = 0; m < 4; ++m)
#pragma unroll
                for (int n = 0; n < 2; ++n) acc[a][b][m][n] = (f32x4){0.f, 0.f, 0.f, 0.f};
    bf16x8 At[4][2], B0[2][2], B1[2][2];
    const char* cA = PG8_UA(cur); const char* cB = PG8_UB(cur);
    PG8_STAGE(PG8_SB(0, 0), cB, voffB); PG8_STAGE(PG8_SB(0, 1), cB + hstepB, voffB); PG8_STAGE(PG8_SA(0, 0), cA, voffA); PG8_STAGE(PG8_SA(0, 1), cA + hstepA, voffA);
    if (wr == 1) PG8_BAR;
    PG8_WAIT_V(2); PG8_BAR;
    PG8_STAGE(PG8_SB(1, 0), cB + kstep, voffB); PG8_STAGE(PG8_SA(1, 0), cA + kstep, voffA); PG8_STAGE(PG8_SB(1, 1), cB + hstepB + kstep, voffB);
    PG8_WAIT_V(6); PG8_BAR;
    for (;;) {
        const bool has_next = S.next(ui + 1, nxt);
        const char* nA = has_next ? PG8_UA(nxt) : cA; const char* nB = has_next ? PG8_UB(nxt) : cB;
        for (int t = 0; t < nt; t += 2) {
            const bool last = (t == nt - 2);
            const char* a1 = cA + (size_t)(t + 1) * kstep;
            const char* a2 = last ? nA : cA + (size_t)(t + 2) * kstep; const char* b2 = last ? nB : cB + (size_t)(t + 2) * kstep;
            const char* a3 = a2 + kstep; const char* b3 = b2 + kstep;
            PG8_LDB(B0, 0, 0); PG8_LDB(B1, 0, 1); PG8_SCHED; PG8_LDA(At, 0, 0); PG8_STAGE(PG8_SA(1, 1), a1 + hstepA, voffA);
            PG8_WAIT_V(8); PG8_WAIT_L(0); PG8_BAR; PG8_MMA(0, 0, At, B0); PG8_MMA(0, 1, At, B1); PG8_BAR; PG8_SCHED;
            PG8_LDA(At, 0, 1); PG8_STAGE(PG8_SB(0, 0), b2, voffB); PG8_STAGE(PG8_SB(0, 1), b2 + hstepB, voffB); PG8_STAGE(PG8_SA(0, 0), a2, voffA);
            PG8_WAIT_V(8); PG8_WAIT_L(0); PG8_BAR; PG8_MMA(1, 0, At, B0); PG8_MMA(1, 1, At, B1); PG8_BAR; PG8_SCHED;
            PG8_LDB(B0, 1, 0); PG8_LDB(B1, 1, 1); PG8_SCHED; PG8_LDA(At, 1, 0); PG8_STAGE(PG8_SA(0, 1), a2 + hstepA, voffA);
            PG8_WAIT_V(8); PG8_WAIT_L(0); PG8_BAR; PG8_MMA(0, 0, At, B0); PG8_MMA(0, 1, At, B1); PG8_BAR; PG8_SCHED;
            PG8_LDA(At, 1, 1); PG8_STAGE(PG8_SB(1, 0), b3, voffB); PG8_STAGE(PG8_SB(1, 1), b3 + hstepB, voffB); PG8_STAGE(PG8_SA(1, 0), a3, voffA);
            PG8_WAIT_V(8); PG8_WAIT_L(0); PG8_BAR; PG8_MMA(1, 0, At, B0); PG8_MMA(1, 1, At, B1); PG8_BAR; PG8_SCHED;
        }
        if constexpr (ALIGN_EPI) { if (wr == 0) PG8_BAR; }
        if constexpr (!Epi::AFTER_DRAIN) { E(acc, cur, wr, wc, fr, fq, wid, lane, ui); }
        if (!has_next) break;
#pragma unroll
        for (int a = 0; a < 2; ++a)
#pragma unroll
            for (int b = 0; b < 2; ++b)
#pragma unroll
                for (int m = 0; m < 4; ++m)
#pragma unroll
                    for (int n = 0; n < 2; ++n) acc[a][b][m][n] = (f32x4){0.f, 0.f, 0.f, 0.f};
        cur = nxt; cA = nA; cB = nB; ++ui;
        if constexpr (ALIGN_EPI) { if (wr == 1) PG8_BAR; }
    }
    PG8_WAIT_V(0);
    if constexpr (!ALIGN_EPI) { if (wr == 0) PG8_BAR; }
    PG8_BAR;
    if constexpr (Epi::AFTER_DRAIN) { E(acc, cur, wr, wc, fr, fq, wid, lane, ui); }
#undef PG8_SA
#undef PG8_SB
#undef PG8_STAGE
#undef PG8_LDA
#undef PG8_LDB
#undef PG8_MMA
#undef PG8_WAIT_V
#undef PG8_WAIT_L
#undef PG8_BAR
#undef PG8_SCHED
#undef PG8_UA
#undef PG8_UB
}
}

namespace att {
typedef LAS const char* lds_cptr;
typedef short v4i16_t __attribute__((ext_vector_type(4)));
constexpr int STAGE = 65536, KV = 64;
__device__ __forceinline__ void glds16(const void* gsrc, unsigned lds_dst) { unsigned keep;
    asm volatile("s_mov_b32 %0, m0\n\ts_mov_b32 m0, %2\n\ts_nop 0\n\tglobal_load_lds_dwordx4 %1, off\n\ts_mov_b32 m0, %0" : "=&s"(keep) : "v"(gsrc), "s"(lds_dst) : "memory"); }
__device__ __forceinline__ v4i16_t vtr(lds_cptr p) { return __builtin_amdgcn_ds_read_tr16_b64_v4i16((LAS v4i16_t*)p); }
typedef float f32x2_t __attribute__((ext_vector_type(2))); typedef __bf16 bf16x2_t __attribute__((ext_vector_type(2)));
__device__ __forceinline__ unsigned cvtpk_s(float lo, float hi) { f32x2_t v = {lo, hi}; bf16x2_t b = __builtin_convertvector(v, bf16x2_t); return __builtin_bit_cast(unsigned, b); }
#define ATT_WAIT_BAR() asm volatile("s_waitcnt vmcnt(0) lgkmcnt(0)\n\ts_barrier" ::: "memory")

template <int IDX> __device__ __forceinline__ void dma_piece(unsigned kvo, unsigned vvo, const char* kbn, const char* vbn, unsigned kdn, unsigned vdn) {
    unsigned keep, tv;
    if constexpr (IDX < 4) {
        constexpr int dl = (IDX & 1) * 16 + (IDX >> 1) * 256; const unsigned dst = kdn + (IDX & 1) * 0x400 + (IDX >> 1) * 0x4000;
        asm volatile("s_mov_b32 %0, m0\n\ts_mov_b32 m0, %3\n\tv_add_u32 %1, %4, %2\n\ts_nop 0\n\tglobal_load_lds_dwordx4 %1, %5\n\ts_mov_b32 m0, %0"
                     : "=&s"(keep), "=&v"(tv) : "v"(kvo), "s"(dst), "i"(dl), "s"(kbn) : "memory");
    } else {
        constexpr int dl = (IDX - 4) * 0x8000; const unsigned dst = vdn + (IDX - 4) * 0x400;
        asm volatile("s_mov_b32 %0, m0\n\ts_mov_b32 m0, %3\n\tv_add_u32 %1, %4, %2\n\ts_nop 0\n\tglobal_load_lds_dwordx4 %1, %5\n\ts_mov_b32 m0, %0"
                     : "=&s"(keep), "=&v"(tv) : "v"(vvo), "s"(dst), "i"(dl), "s"(vbn) : "memory");
    }
}
template <bool SHIFT> __device__ __forceinline__ void attn_item(int h, int qb, const bf16_t* Q, const bf16_t* Kt, const bf16_t* V, bf16_t* O, char* shm, float lam, float osc, const float* subg, float cshift, int wv) {
    int tid_ = (wv << 6) | lane_id(); asm volatile("" : "+v"(tid_));
    const int tid = tid_, lane = tid & 63, r32 = lane & 31, hi = lane >> 5;
    const int wid = __builtin_amdgcn_readfirstlane(tid >> 6), comp = wid >> 2, w = wid & 3;
    const int q0 = qb * 128;
    const unsigned lds0 = (unsigned)(uintptr_t)shm;
    const lds_cptr shm3 = (lds_cptr)shm;
    const unsigned kvo = (unsigned)(lane * D + wid * 16) * 2u;
    const unsigned vvo = (unsigned)((lane >> 2) * D + wid * 32 + (lane & 3) * 8) * 2u;
    const char* kbase = (const char*)(Kt + h * 256);
    const char* vbase = (const char*)(V + h * 256);
    const int NT = 2 * qb + 2, NTw = 2 * qb + 1 + (w >> 1);
#define ATT_DMA(t, st) do { const char* kb_ = kbase + (size_t)(t) * (KV * D * 2); const char* vb_ = vbase + (size_t)(t) * (KV * D * 2); \
        const unsigned kd_ = (unsigned)__builtin_amdgcn_readfirstlane(lds0 + (st) + wid * 2048), vd_ = (unsigned)__builtin_amdgcn_readfirstlane(lds0 + (st) + 32768 + wid * 4096); \
        unsigned keep_, tv_; \
        asm volatile("s_nop 4\n\ts_mov_b32 %0, m0\n\ts_mov_b32 m0, %4\n\ts_nop 0\n\t" \
                     "global_load_lds_dwordx4 %2, %6\n\tv_add_u32 %1, 16, %2\n\ts_add_u32 m0, m0, 0x400\n\ts_nop 0\n\t" \
                     "global_load_lds_dwordx4 %1, %6\n\tv_add_u32 %1, 0x100, %2\n\ts_add_u32 m0, m0, 0x3c00\n\ts_nop 0\n\t" \
                     "global_load_lds_dwordx4 %1, %6\n\tv_add_u32 %1, 0x110, %2\n\ts_add_u32 m0, m0, 0x400\n\ts_nop 0\n\t" \
                     "global_load_lds_dwordx4 %1, %6\n\ts_mov_b32 m0, %5\n\ts_nop 0\n\t" \
                     "global_load_lds_dwordx4 %3, %7\n\tv_add_u32 %1, 0x8000, %3\n\ts_add_u32 m0, m0, 0x400\n\ts_nop 0\n\t" \
                     "global_load_lds_dwordx4 %1, %7\n\tv_add_u32 %1, 0x8000, %1\n\ts_add_u32 m0, m0, 0x400\n\ts_nop 0\n\t" \
                     "global_load_lds_dwordx4 %1, %7\n\tv_add_u32 %1, 0x8000, %1\n\ts_add_u32 m0, m0, 0x400\n\ts_nop 0\n\t" \
                     "global_load_lds_dwordx4 %1, %7\n\ts_mov_b32 m0, %0" \
                     : "=&s"(keep_), "=&v"(tv_) : "v"(kvo), "v"(vvo), "s"(kd_), "s"(vd_), "s"(kb_), "s"(vb_) : "memory", "scc"); } while (0)
    ATT_DMA(0, 0);
    bf16x8 qr[8];
    { const bf16_t* qp = Q + (size_t)(q0 + 32 * w + r32) * D + h * 256 + comp * 128 + hi * 8;
#pragma unroll
      for (int ks = 0; ks < 8; ++ks) qr[ks] = *(const bf16x8*)(qp + ks * 16); }
    f32x16 o[8];
#pragma unroll
    for (int d0 = 0; d0 < 8; ++d0) o[d0] = f32x16{};
    float lsum = 0.f;
    const int koff = comp * 16384 + hi * 1024 + r32 * 16;
    const int voff = 32768 + ((r32 >> 4) & 1) * 32 + (r32 & 3) * 8 + (4 * hi + ((r32 & 15) >> 2)) * 64;
#define ATT_SB() __builtin_amdgcn_sched_barrier(0)
    for (int t = 0; t < NT; ++t) {
        const int st = (t & 1) * STAGE;
        ATT_WAIT_BAR();
        const bool has_next = (t + 1 < NT);
        const char* kbn = kbase + (size_t)(t + 1) * (KV * D * 2); const char* vbn = vbase + (size_t)(t + 1) * (KV * D * 2);
        const unsigned kdn = (unsigned)__builtin_amdgcn_readfirstlane(lds0 + (STAGE - st) + wid * 2048), vdn = (unsigned)__builtin_amdgcn_readfirstlane(lds0 + (STAGE - st) + 32768 + wid * 4096);
        if (t >= NTw) { if (has_next) ATT_DMA(t + 1, STAGE - st); }
        if (t < NTw) {
            const lds_cptr kb = shm3 + st + koff;
            const lds_cptr vb = shm3 + st + voff;
#define ATT_KFRAG(i_) (*(const LAS bf16x8*)(kb + ((i_) & 7) * 2048 + ((i_) >> 3) * 512))
#define ATT_VFRAG(dst, j_) do { const v4i16_t lo_ = vtr(vb + ((j_) & 7) * 4096 + ((j_) >> 3) * 1024), hh_ = vtr(vb + ((j_) & 7) * 4096 + ((j_) >> 3) * 1024 + 512); \
        dst = (bf16x8){lo_[0], lo_[1], lo_[2], lo_[3], hh_[0], hh_[1], hh_[2], hh_[3]}; } while (0)
            f32x16 s0, s1;
            u32x4 pw[4];
            bf16x8 kf[3], vf[3];
            float sa = 0.f, sb = 0.f;
            kf[0] = ATT_KFRAG(0); kf[1] = ATT_KFRAG(1);
#pragma unroll
            for (int i = 0; i < 16; ++i) {
                if (i + 2 < 16) kf[(i + 2) % 3] = ATT_KFRAG(i + 2);
                if ((i & 3) == 2) { if (has_next) { switch (i >> 2) {
                    case 0: dma_piece<0>(kvo, vvo, kbn, vbn, kdn, vdn); break; case 1: dma_piece<1>(kvo, vvo, kbn, vbn, kdn, vdn); break;
                    case 2: dma_piece<2>(kvo, vvo, kbn, vbn, kdn, vdn); break; default: dma_piece<3>(kvo, vvo, kbn, vbn, kdn, vdn); break; } } }
                if (i == 14) ATT_VFRAG(vf[0], 0);
                if (i == 15) ATT_VFRAG(vf[1], 1);
                if (i < 8) {
                    if (i == 0) s0 = __builtin_amdgcn_mfma_f32_32x32x16_bf16(kf[0], qr[0], f32x16{}, 0, 0, 0);
                    else s0 = __builtin_amdgcn_mfma_f32_32x32x16_bf16(kf[i % 3], qr[i], s0, 0, 0, 0);
                } else {
                    const int ks = i - 8;
                    if (ks == 0) s1 = __builtin_amdgcn_mfma_f32_32x32x16_bf16(kf[i % 3], qr[0], f32x16{}, 0, 0, 0);
                    else s1 = __builtin_amdgcn_mfma_f32_32x32x16_bf16(kf[i % 3], qr[ks], s1, 0, 0, 0);
                    s0[2 * ks] = __builtin_amdgcn_exp2f(SHIFT ? s0[2 * ks] - cshift : s0[2 * ks]); s0[2 * ks + 1] = __builtin_amdgcn_exp2f(SHIFT ? s0[2 * ks + 1] - cshift : s0[2 * ks + 1]);
                    if (ks >= 1) { sa += s0[2 * ks - 2] + s0[2 * ks - 1]; pw[(ks - 1) >> 2][(ks - 1) & 3] = cvtpk_s(s0[2 * ks - 2], s0[2 * ks - 1]); }
                }
                ATT_SB();
            }
#pragma unroll
            for (int j = 0; j < 32; ++j) {
                if (j + 2 < 32) ATT_VFRAG(vf[(j + 2) % 3], j + 2);
                if ((j & 3) == 1 && j < 16) { if (has_next) { switch (4 + (j >> 2)) {
                    case 0: dma_piece<0>(kvo, vvo, kbn, vbn, kdn, vdn); break; case 1: dma_piece<1>(kvo, vvo, kbn, vbn, kdn, vdn); break;
                    case 2: dma_piece<2>(kvo, vvo, kbn, vbn, kdn, vdn); break; case 3: dma_piece<3>(kvo, vvo, kbn, vbn, kdn, vdn); break;
                    case 4: dma_piece<4>(kvo, vvo, kbn, vbn, kdn, vdn); break; case 5: dma_piece<5>(kvo, vvo, kbn, vbn, kdn, vdn); break;
                    case 6: dma_piece<6>(kvo, vvo, kbn, vbn, kdn, vdn); break; default: dma_piece<7>(kvo, vvo, kbn, vbn, kdn, vdn); break; } } }
                o[j & 7] = __builtin_amdgcn_mfma_f32_32x32x16_bf16(vf[j % 3], __builtin_bit_cast(bf16x8, pw[j >> 3]), o[j & 7], 0, 0, 0);
                if (j == 0) { sa += s0[14] + s0[15]; pw[1][3] = cvtpk_s(s0[14], s0[15]); }
                if (j < 16) s1[j] = __builtin_amdgcn_exp2f(SHIFT ? s1[j] - cshift : s1[j]);
                if (j >= 1 && j < 17) sb += s1[j - 1];
                if (j >= 2 && j < 18 && !(j & 1)) pw[2 + ((j - 2) >> 3)][((j - 2) & 7) >> 1] = cvtpk_s(s1[j - 2], s1[j - 1]);
                ATT_SB();
            }
            lsum += sa + sb;
#undef ATT_KFRAG
#undef ATT_VFRAG
        }
    }
#undef ATT_SB
    const float l = xor32_sum(lsum);
    const float inv = 1.0f / l;
    ATT_WAIT_BAR();
    LAS f32x4* X = (LAS f32x4*)shm;
    if (comp == 1) {
        const float sc = inv * lam;
#pragma unroll
        for (int d0 = 0; d0 < 8; ++d0)
#pragma unroll
            for (int r4 = 0; r4 < 4; ++r4)
                { X[(w * 32 + d0 * 4 + r4) * 64 + lane] = (f32x4){o[d0][4 * r4] * sc, o[d0][4 * r4 + 1] * sc, o[d0][4 * r4 + 2] * sc, o[d0][4 * r4 + 3] * sc}; __builtin_amdgcn_sched_barrier(0); }
    }
    ATT_WAIT_BAR();
    if (comp == 0) {
        float ss = 0.f;
#pragma unroll
        for (int d0 = 0; d0 < 8; ++d0)
#pragma unroll
            for (int r4 = 0; r4 < 4; ++r4) {
                const f32x4 x = X[(w * 32 + d0 * 4 + r4) * 64 + lane];
#pragma unroll
                for (int i = 0; i < 4; ++i) { const float dd = o[d0][4 * r4 + i] * inv - x[i]; o[d0][4 * r4 + i] = dd; ss += dd * dd; }
                if (r4 == 3) __builtin_amdgcn_sched_barrier(0);
            }
        ss = xor32_sum(ss);
        const float rstd = __builtin_amdgcn_rsqf(ss * (1.0f / 256.0f) + NORM_EPS) * osc;
        bf16_t* orow = O + (size_t)(q0 + 32 * w + r32) * D + h * 256 + 4 * hi;
#pragma unroll
        for (int d0 = 0; d0 < 8; ++d0)
#pragma unroll
            for (int r4 = 0; r4 < 4; ++r4) {
                const int dv = 32 * d0 + 8 * r4;
                const f32x4 g4 = *(const f32x4*)(subg + dv + 4 * hi);
                u32x2 wv; wv.x = cvt_pk_bf16(o[d0][4 * r4] * rstd * g4[0], o[d0][4 * r4 + 1] * rstd * g4[1]); wv.y = cvt_pk_bf16(o[d0][4 * r4 + 2] * rstd * g4[2], o[d0][4 * r4 + 3] * rstd * g4[3]);
                *(u32x2*)(orow + dv) = wv;
                if (r4 == 3) __builtin_amdgcn_sched_barrier(0);
            }
    }
    ATT_WAIT_BAR();
#undef ATT_DMA
}

template <int IDX> __device__ __forceinline__ void dma_piece2(unsigned kvo, unsigned vvo, const char* kbn, const char* vbn, unsigned kdn, unsigned vdn) {
    unsigned keep, tv;
    if constexpr (IDX < 2) {
        constexpr int dl = IDX * 16; const unsigned dst = kdn + IDX * 0x400;
        asm volatile("s_mov_b32 %0, m0\n\ts_mov_b32 m0, %3\n\tv_add_u32 %1, %4, %2\n\ts_nop 0\n\tglobal_load_lds_dwordx4 %1, %5\n\ts_mov_b32 m0, %0"
                     : "=&s"(keep), "=&v"(tv) : "v"(kvo), "s"(dst), "i"(dl), "s"(kbn) : "memory");
    } else {
        constexpr int dl = (IDX - 2) * 0x8000; const unsigned dst = vdn + (IDX - 2) * 0x400;
        asm volatile("s_mov_b32 %0, m0\n\ts_mov_b32 m0, %3\n\tv_add_u32 %1, %4, %2\n\ts_nop 0\n\tglobal_load_lds_dwordx4 %1, %5\n\ts_mov_b32 m0, %0"
                     : "=&s"(keep), "=&v"(tv) : "v"(vvo), "s"(dst), "i"(dl), "s"(vbn) : "memory");
    }
}
template <bool SHIFT> __device__ __forceinline__ void attn_item2(int h, int comp, int qb, const bf16_t* Q, const bf16_t* Kt, const bf16_t* V, bf16_t* O, char* shm, float oscale, float cshift, int wv) {
    constexpr int STG = 49152, VOFF = 16384;
    int tid_ = (wv << 6) | lane_id(); asm volatile("" : "+v"(tid_));
    const int tid = tid_, lane = tid & 63, r32 = lane & 31, hi = lane >> 5;
    const int wid = __builtin_amdgcn_readfirstlane(tid >> 6);
    const int q0 = qb * 256;
    const unsigned lds0 = (unsigned)(uintptr_t)shm;
    const lds_cptr shm3 = (lds_cptr)shm;
    const unsigned kvo = (unsigned)(lane * D + wid * 16) * 2u;
    const unsigned vvo = (unsigned)((lane >> 2) * D + wid * 32 + (lane & 3) * 8) * 2u;
    const char* kbase = (const char*)(Kt + h * 256 + comp * 128);
    const char* vbase = (const char*)(V + h * 256);
    const int NT = 4 * qb + 4, NTw = 4 * qb + 1 + (wid >> 1);
    {
        const unsigned kd0 = (unsigned)__builtin_amdgcn_readfirstlane(lds0 + wid * 2048), vd0 = (unsigned)__builtin_amdgcn_readfirstlane(lds0 + VOFF + wid * 4096);
        dma_piece2<0>(kvo, vvo, kbase, vbase, kd0, vd0); dma_piece2<1>(kvo, vvo, kbase, vbase, kd0, vd0); dma_piece2<2>(kvo, vvo, kbase, vbase, kd0, vd0);
        dma_piece2<3>(kvo, vvo, kbase, vbase, kd0, vd0); dma_piece2<4>(kvo, vvo, kbase, vbase, kd0, vd0); dma_piece2<5>(kvo, vvo, kbase, vbase, kd0, vd0);
    }
    bf16x8 qr[8];
    { const bf16_t* qp = Q + (size_t)(q0 + 32 * wid + r32) * D + h * 256 + comp * 128 + hi * 8;
#pragma unroll
      for (int ks = 0; ks < 8; ++ks) qr[ks] = *(const bf16x8*)(qp + ks * 16); }
    f32x16 o[8];
#pragma unroll
    for (int d0 = 0; d0 < 8; ++d0) o[d0] = f32x16{};
    float lsum = 0.f;
    const int koff = hi * 1024 + r32 * 16;
    const int voff = VOFF + ((r32 >> 4) & 1) * 32 + (r32 & 3) * 8 + (4 * hi + ((r32 & 15) >> 2)) * 64;
#define ATT_SB() __builtin_amdgcn_sched_barrier(0)
#define ATT_KFRAG(i_) (*(const LAS bf16x8*)(kb + ((i_) & 7) * 2048 + ((i_) >> 3) * 512))
#define ATT_VFRAG(dst, j_) do { const v4i16_t lo_ = vtr(vb + ((j_) & 7) * 4096 + ((j_) >> 3) * 1024), hh_ = vtr(vb + ((j_) & 7) * 4096 + ((j_) >> 3) * 1024 + 512); \
        dst = (bf16x8){lo_[0], lo_[1], lo_[2], lo_[3], hh_[0], hh_[1], hh_[2], hh_[3]}; } while (0)
#define ATT_P2(ix) dma_piece2<ix>(kvo, vvo, kbn, vbn, kdn, vdn)
    for (int t = 0; t < NT; ++t) {
        const int st = (t & 1) * STG;
        ATT_WAIT_BAR();
        const bool has_next = (t + 1 < NT);
        const char* kbn = kbase + (size_t)(t + 1) * (KV * D * 2); const char* vbn = vbase + (size_t)(t + 1) * (KV * D * 2);
        const unsigned kdn = (unsigned)__builtin_amdgcn_readfirstlane(lds0 + (STG - st) + wid * 2048), vdn = (unsigned)__builtin_amdgcn_readfirstlane(lds0 + (STG - st) + VOFF + wid * 4096);
        if (t >= NTw) { if (has_next) { ATT_P2(0); ATT_P2(1); ATT_P2(2); ATT_P2(3); ATT_P2(4); ATT_P2(5); } }
        if (t < NTw) {
            const lds_cptr kb = shm3 + st + koff;
            const lds_cptr vb = shm3 + st + voff;
            f32x16 s0, s1;
            u32x4 pw[4];
            bf16x8 kf[3], vf[3];
            float sa = 0.f, sb = 0.f;
            kf[0] = ATT_KFRAG(0); kf[1] = ATT_KFRAG(1);
#pragma unroll
            for (int i = 0; i < 16; ++i) {
                if (i + 2 < 16) kf[(i + 2) % 3] = ATT_KFRAG(i + 2);
                if (i == 4) { if (has_next) ATT_P2(0); }
                if (i == 12) { if (has_next) ATT_P2(1); }
                if (i == 14) ATT_VFRAG(vf[0], 0);
                if (i == 15) ATT_VFRAG(vf[1], 1);
                if (i < 8) {
                    if (i == 0) s0 = __builtin_amdgcn_mfma_f32_32x32x16_bf16(kf[0], qr[0], f32x16{}, 0, 0, 0);
                    else s0 = __builtin_amdgcn_mfma_f32_32x32x16_bf16(kf[i % 3], qr[i], s0, 0, 0, 0);
                } else {
                    const int ks = i - 8;
                    if (ks == 0) s1 = __builtin_amdgcn_mfma_f32_32x32x16_bf16(kf[i % 3], qr[0], f32x16{}, 0, 0, 0);
                    else s1 = __builtin_amdgcn_mfma_f32_32x32x16_bf16(kf[i % 3], qr[ks], s1, 0, 0, 0);
                    s0[2 * ks] = __builtin_amdgcn_exp2f(SHIFT ? s0[2 * ks] - cshift : s0[2 * ks]); s0[2 * ks + 1] = __builtin_amdgcn_exp2f(SHIFT ? s0[2 * ks + 1] - cshift : s0[2 * ks + 1]);
                    if (ks >= 1) { sa += s0[2 * ks - 2] + s0[2 * ks - 1]; pw[(ks - 1) >> 2][(ks - 1) & 3] = cvtpk_s(s0[2 * ks - 2], s0[2 * ks - 1]); }
                }
                ATT_SB();
            }
#pragma unroll
            for (int j = 0; j < 32; ++j) {
                if (j + 2 < 32) ATT_VFRAG(vf[(j + 2) % 3], j + 2);
                if (j == 1) { if (has_next) ATT_P2(2); }
                if (j == 5) { if (has_next) ATT_P2(3); }
                if (j == 9) { if (has_next) ATT_P2(4); }
                if (j == 13) { if (has_next) ATT_P2(5); }
                o[j & 7] = __builtin_amdgcn_mfma_f32_32x32x16_bf16(vf[j % 3], __builtin_bit_cast(bf16x8, pw[j >> 3]), o[j & 7], 0, 0, 0);
                if (j == 0) { sa += s0[14] + s0[15]; pw[1][3] = cvtpk_s(s0[14], s0[15]); }
                if (j < 16) s1[j] = __builtin_amdgcn_exp2f(SHIFT ? s1[j] - cshift : s1[j]);
                if (j >= 1 && j < 17) sb += s1[j - 1];
                if (j >= 2 && j < 18 && !(j & 1)) pw[2 + ((j - 2) >> 3)][((j - 2) & 7) >> 1] = cvtpk_s(s1[j - 2], s1[j - 1]);
                ATT_SB();
            }
            lsum += sa + sb;
        }
    }
#undef ATT_SB
#undef ATT_KFRAG
#undef ATT_VFRAG
#undef ATT_P2
    const float sc = oscale / xor32_sum(lsum);
    ATT_WAIT_BAR();
    LAS unsigned char* stg = (LAS unsigned char*)shm + wid * 16896;
#pragma unroll
    for (int d0 = 0; d0 < 8; ++d0)
#pragma unroll
        for (int r4 = 0; r4 < 4; ++r4) {
            const int dv = 32 * d0 + 8 * r4 + 4 * hi;
            u32x2 wv2; wv2.x = cvt_pk_bf16(o[d0][4 * r4] * sc, o[d0][4 * r4 + 1] * sc); wv2.y = cvt_pk_bf16(o[d0][4 * r4 + 2] * sc, o[d0][4 * r4 + 3] * sc);
            *(LAS u32x2*)(stg + r32 * 528 + dv * 2) = wv2;
            if (r4 == 3) __builtin_amdgcn_sched_barrier(0);
        }
    asm volatile("s_waitcnt lgkmcnt(0)" ::: "memory");
    bf16_t* obase = O + (size_t)(q0 + 32 * wid) * D + h * 256 + (lane & 31) * 8;
#pragma unroll
    for (int i = 0; i < 16; ++i) {
        const int row = 2 * i + (lane >> 5);
        const u32x4 v = *(const LAS u32x4*)(stg + row * 528 + (lane & 31) * 16);
        *(u32x4*)(obase + (size_t)row * D) = v;
    }
    ATT_WAIT_BAR();
}
}

struct Args { const float* in[16]; float* out; unsigned char* ws; float invf[16]; };

__device__ __forceinline__ float wave_sum(float v) {
#pragma unroll
    for (int o = 1; o < 64; o <<= 1) v += __shfl_xor(v, o);
    return v;
}
__device__ __forceinline__ float wave_max(float v) {
#pragma unroll
    for (int o = 1; o < 64; o <<= 1) v = fmaxf(v, __shfl_xor(v, o));
    return v;
}
__device__ __forceinline__ unsigned f2bf(float f) { unsigned u = __builtin_bit_cast(unsigned, f); return (u + 0x7fffu + ((u >> 16) & 1u)) >> 16; }
__device__ __forceinline__ unsigned pk2(float lo, float hi) { return f2bf(lo) | (f2bf(hi) << 16); }

__device__ __forceinline__ void p0_transpose_item(const float* W, int K, int N, bf16_t* WT, int dest_row0, const float* gk, LAS float* scr, int k0, int n0, int lane) {
    float wv_[32];
    const float* wp = W + (size_t)(k0 + (lane >> 5)) * N + n0 + (lane & 31);
#pragma unroll
    for (int i = 0; i < 32; ++i) wv_[i] = wp[(size_t)(2 * i) * N];
    if (gk) {
#pragma unroll
        for (int i = 0; i < 32; ++i) wv_[i] *= gk[k0 + 2 * i + (lane >> 5)];
    }
#pragma unroll
    for (int i = 0; i < 32; ++i) scr[(2 * i + (lane >> 5)) * 33 + (lane & 31)] = wv_[i];
    asm volatile("s_waitcnt lgkmcnt(0)" ::: "memory");
    const int c = lane & 7;
#pragma unroll
    for (int j = 0; j < 4; ++j) { const int n = (lane >> 3) + 8 * j; const LAS float* s = scr + (8 * c) * 33 + n;
        u32x4 o; o.x = cvt_pk_bf16(s[0 * 33], s[1 * 33]); o.y = cvt_pk_bf16(s[2 * 33], s[3 * 33]); o.z = cvt_pk_bf16(s[4 * 33], s[5 * 33]); o.w = cvt_pk_bf16(s[6 * 33], s[7 * 33]);
        *(u32x4*)(WT + (size_t)(dest_row0 + n) * K + k0 + 8 * c) = o; }
    asm volatile("s_waitcnt lgkmcnt(0)" ::: "memory");
}

__device__ __forceinline__ void sincos_d(float angf, float& sn, float& cs) {
    const double a = (double)angf;
    const double n = rint(a * 0.63661977236758134308);
    double r = fma(-n, 1.57079632679489655800, a); r = fma(-n, 6.12323399573676603587e-17, r);
    const int q = ((int)n) & 3;
    const double r2 = r * r;
    const double sp = r * (1.0 + r2 * (-1.0 / 6 + r2 * (1.0 / 120 + r2 * (-1.0 / 5040 + r2 * (1.0 / 362880 + r2 * (-1.0 / 39916800 + r2 * (1.0 / 6227020800.0)))))));
    const double cp = 1.0 + r2 * (-0.5 + r2 * (1.0 / 24 + r2 * (-1.0 / 720 + r2 * (1.0 / 40320 + r2 * (-1.0 / 3628800 + r2 * (1.0 / 479001600.0 + r2 * (-1.0 / 87178291200.0)))))));
    const double s_ = (q == 0) ? sp : (q == 1) ? cp : (q == 2) ? -sp : -cp;
    const double c_ = (q == 0) ? cp : (q == 1) ? -sp : (q == 2) ? -cp : sp;
    sn = (float)s_; cs = (float)c_;
}

__device__ __forceinline__ void pooled_tile(const bf16_t* up, bf16_t* pooled, int pm, int g, int tid) {
    asm volatile("" : "+v"(tid));
    const int col = 256 * g + 8 * (tid & 31), wdw = 2 << g, t0 = 256 * pm + 16 * (tid >> 5);
    f32x4 sA = {0.f, 0.f, 0.f, 0.f}, sB = {0.f, 0.f, 0.f, 0.f};
    for (int i = 1; i <= wdw; ++i) { const int t = t0 - i; if (t >= 0) { f32x4 a, b; unpack8(*(const u32x4*)(up + (size_t)t * D + col), a, b); sA += a; sB += b; } }
#pragma unroll 4
    for (int tt = 0; tt < 16; ++tt) {
        const int t = t0 + tt;
        f32x4 ca, cb; unpack8(*(const u32x4*)(up + (size_t)t * D + col), ca, cb);
        sA += ca; sB += cb;
        if (t - wdw >= 0) { f32x4 a, b; unpack8(*(const u32x4*)(up + (size_t)(t - wdw) * D + col), a, b); sA -= a; sB -= b; }
        const float rc = 1.0f / (float)((t + 1 < wdw) ? (t + 1) : wdw);
        *(u32x4*)(pooled + (size_t)t * D + col) = pack8(sA * rc - ca, sB * rc - cb);
    }
}

__device__ __forceinline__ void fill_rstd(LAS float* xl, const float* ssq, const pg8::StaticOrder& S, int tid) {
    if (tid < 256) {
#pragma unroll
        for (int i = 0; i < 6; ++i) { pg8::Unit u; if (S.next(i, u)) { const int r = u.pm * 256 + tid;
            xl[XL_BYTES / 4 + i * 256 + tid] = __builtin_amdgcn_rsqf(((ssq[r] + ssq[M + r]) + (ssq[2 * M + r] + ssq[3 * M + r])) * (1.0f / 1024.0f) + NORM_EPS); } }
    }
    __syncthreads();
}
typedef const __attribute__((address_space(4))) Args* KArgsPtr;
#define KARGS(ap) KArgsPtr ap = (KArgsPtr)__builtin_amdgcn_kernarg_segment_ptr(); asm volatile("" : "+s"(ap))

__global__ void __launch_bounds__(NTHREADS, 2) fwd_megakernel(Args args_unused) {
    extern __shared__ __attribute__((aligned(16))) unsigned char lds_raw[];
    cg::grid_group grid = cg::this_grid();
    LAS unsigned char* lds = (LAS unsigned char*)lds_raw;
    LAS float* xl = (LAS float*)(lds + XL_OFF);
    const int wv = __builtin_amdgcn_readfirstlane(threadIdx.x >> 6);
    volatile LAS unsigned* bst = (volatile LAS unsigned*)(lds + LDS_BYTES - 16);
    if (wv == 0) { if (lane_id() == 0) { bst[0] = 0u; bst[1] = 0u; KARGS(ap0); (void)xb_add((unsigned*)(ap0->ws + WS_BAR) + XB_XCNT(xb_xcc_id()), 1u); } }
    __syncthreads();
#define GRID_BAR() do { KARGS(apb); grid_barrier((unsigned*)(apb->ws + WS_BAR), bst, wv); } while (0)
    if (gridDim.x == 0x7fffffffu) grid.sync();

    {
        KARGS(ap);
        unsigned char* ws = ap->ws;
        const int bx = blockIdx.x, G = gridDim.x, vcu = (bx % 8) * (G / 8) + bx / 8;
        int tid = (wv << 6) | lane_id(); asm volatile("" : "+v"(tid));
        const int lane = tid & 63, wave = wv;
        LAS float* scr = (LAS float*)(lds + wave * 16384);
        const int gw = vcu * NWAVES + wave, NGW = G * NWAVES;
        constexpr int I_IN = 16 * 192, I_OUT = 16 * 32, I_FF = 16 * 176, I_FO = 44 * 32, I_PL = 128, I_LAYER = I_IN + I_OUT + I_FF + I_FO + I_PL;
        for (int it = gw; it < DEPTH * I_LAYER; it += NGW) {
            const int L = it / I_LAYER; int r = it % I_LAYER;
            unsigned char* wl = ws + WS_W + (size_t)L * LAYER_W;
            if (r < I_IN) { const int kb = r / 192, nb = r % 192;
                p0_transpose_item(ap->in[2] + (size_t)L * D * NIN, D, NIN, (bf16_t*)(wl + OFF_WIN), 32 * nb, ap->in[1] + L * D, scr, 64 * kb, 32 * nb, lane); continue; }
            r -= I_IN;
            if (r < I_OUT) { const int kb = r / 32, nb = r % 32;
                p0_transpose_item(ap->in[12] + (size_t)L * D * D, D, D, (bf16_t*)(wl + OFF_WOUT), 32 * nb, nullptr, scr, 64 * kb, 32 * nb, lane); continue; }
            r -= I_OUT;
            if (r < I_FF) { const int kb = r / 176, nb = r % 176; const int n0 = 32 * nb, up = (n0 >= FF) ? 1 : 0, j = n0 - up * FF;
                p0_transpose_item(ap->in[14] + (size_t)L * D * NFF2, D, NFF2, (bf16_t*)(wl + OFF_WFF), 256 * (j / 128) + 128 * up + (j % 128), ap->in[13] + L * D, scr, 64 * kb, n0, lane); continue; }
            r -= I_FF;
            if (r < I_FO) { const int kb = r / 32, nb = r % 32;
                p0_transpose_item(ap->in[15] + (size_t)L * FF * D, FF, D, (bf16_t*)(wl + OFF_WFO), 32 * nb, nullptr, scr, 64 * kb, 32 * nb, lane); continue; }
            r -= I_FO;
            { const int gg = r / 32, rr = r % 32, kb = rr / 8, nb = rr % 8;
                p0_transpose_item(ap->in[10] + (size_t)L * 4 * 65536 + (size_t)gg * 65536, 256, 256, (bf16_t*)(wl + OFF_POOL) + (size_t)gg * 65536, 32 * nb, nullptr, scr, 64 * kb, 32 * nb, lane); }
        }
        const float* x_in = ap->in[0];
        bf16_t* xb = (bf16_t*)(ws + WS_XB); float* ssq = (float*)(ws + WS_SSQ);
        for (int m = gw; m < M; m += NGW) {
            const f32x4* xr = (const f32x4*)(x_in + (size_t)m * D) + lane;
            float s = 0.f;
#pragma unroll
            for (int j = 0; j < 4; ++j) { const f32x4 v = xr[64 * j]; s += (v[0] * v[0] + v[1] * v[1]) + (v[2] * v[2] + v[3] * v[3]);
                u32x2 w2; w2.x = cvt_pk_bf16(v[0], v[1]); w2.y = cvt_pk_bf16(v[2], v[3]); *((u32x2*)(xb + (size_t)m * D) + lane + 64 * j) = w2; }
            s = wave_sum(s);
            if (lane < 4) ssq[(size_t)lane * M + m] = (lane == 0) ? s : 0.f;
        }
        float* rcos = (float*)(ws + WS_COS); float* rsin = (float*)(ws + WS_SIN);
        for (int idx = vcu * NTHREADS + tid; idx < M * 16; idx += G * NTHREADS) {
            const int pos = idx >> 4, j = idx & 15;
            const float ang = (float)pos * ap->invf[j];
            float sn, cs; sincos_d(ang, sn, cs);
            rcos[idx] = cs; rsin[idx] = sn;
        }
    }
    GRID_BAR();

#pragma unroll 1
    for (int L = 0; L < DEPTH; ++L) {
        {
            KARGS(ap); unsigned char* ws = ap->ws; unsigned char* wl = ws + WS_W + (size_t)L * LAYER_W;
            pg8::Gemm g{(const bf16_t*)(ws + WS_XB), (const bf16_t*)(wl + OFF_WIN), D, D, D, 0};
            int bxl = blockIdx.x; asm volatile("" : "+s"(bxl)); pg8::StaticOrder S; S.init(M, NIN, GRID, bxl);
            pg8::EpiIn E{ws, ap->in[3] + L * 128, ap->in[4] + L * 128, xl};
            fill_rstd(xl, (const float*)(ws + WS_SSQ), S, (wv << 6) | lane_id());
            pg8::gemm_phase<pg8::EpiIn, true>(lds, g, S, E, wv);
        }
        GRID_BAR();
        {
            KARGS(ap); unsigned char* ws = ap->ws;
            int ln = lane_id(); asm volatile("" : "+v"(ln));
            const float lam_init = 0.8f - 0.6f * expf(-0.3f * (float)L);
            const float* lq1 = ap->in[5] + L * 128; const float* lk1 = ap->in[6] + L * 128; const float* lq2 = ap->in[7] + L * 128; const float* lk2 = ap->in[8] + L * 128;
            const float d1 = wave_sum_rl(lq1[ln] * lk1[ln] + lq1[ln + 64] * lk1[ln + 64]);
            const float d2 = wave_sum_rl(lq2[ln] * lk2[ln] + lq2[ln + 64] * lk2[ln + 64]);
            const float lam = expf(d1) - expf(d2) + lam_init;
            const float* gq = ap->in[3] + L * 128; const float* gk = ap->in[4] + L * 128;
            const float mq = wave_max_rl(fmaxf(fabsf(gq[ln]), fabsf(gq[ln + 64]))), mk = wave_max_rl(fmaxf(fabsf(gk[ln]), fabsf(gk[ln + 64])));
            const float cshift = 11.313708498984761f * 1.4426950408889634f * mq * mk;
            int bx = blockIdx.x; asm volatile("" : "+s"(bx)); const int vcu = (bx % 8) * (GRID / 8) + bx / 8;
            const int hc = vcu >> 5, p = vcu & 31, h = hc >> 1, comp = hc & 1;
            const bf16_t* act0 = (const bf16_t*)(ws + WS_ACT);
            const bf16_t* Qb = act0 + ACT_ELEMS; const bf16_t* Kb = act0 + 2 * ACT_ELEMS; const bf16_t* Vb = act0 + 3 * ACT_ELEMS;
            bf16_t* Oc = (bf16_t*)(ws + (comp ? WS_XB : WS_ATTN));
            const float oscale = comp ? lam : 1.0f;
            if (cshift <= 64.0f) {
                att::attn_item2<false>(h, comp, 63 - p, Qb, Kb, Vb, Oc, (char*)lds_raw, oscale, 0.0f, wv);
                att::attn_item2<false>(h, comp, p, Qb, Kb, Vb, Oc, (char*)lds_raw, oscale, 0.0f, wv);
            } else {
                att::attn_item2<true>(h, comp, 63 - p, Qb, Kb, Vb, Oc, (char*)lds_raw, oscale, cshift, wv);
                att::attn_item2<true>(h, comp, p, Qb, Kb, Vb, Oc, (char*)lds_raw, oscale, cshift, wv);
            }
        }
        GRID_BAR();
        {
            KARGS(ap); unsigned char* ws = ap->ws; unsigned char* wl = ws + WS_W + (size_t)L * LAYER_W;
            bf16_t* act0 = (bf16_t*)(ws + WS_ACT);
            int bxl = blockIdx.x; asm volatile("" : "+s"(bxl)); pg8::StaticOrder S; S.init(M, D, GRID, bxl);
            pg8::Unit u;
            (void)S.next(0, u); pooled_tile(act0, (bf16_t*)(ws + WS_POOLED), u.pm, u.pn, (wv << 6) | lane_id());
            asm volatile("s_waitcnt vmcnt(0)" ::: "memory");
            __syncthreads();
            pg8::Gemm g{(const bf16_t*)(ws + WS_POOLED), (const bf16_t*)(wl + OFF_POOL), D, 256, 256, 256};
            pg8::EpiMerge E{act0 + 4 * ACT_ELEMS, act0 + 5 * ACT_ELEMS, (const bf16_t*)(ws + WS_ATTN), (const bf16_t*)(ws + WS_XB), ap->in[11] + L * D, ap->in[9] + L * 256, (bf16_t*)(ws + WS_MERGED),
                            1.0f - (0.8f - 0.6f * expf(-0.3f * (float)L)), xl};
            pg8::gemm_phase<pg8::EpiMerge, false>(lds, g, S, E, wv);
        }
        GRID_BAR();
        {
            KARGS(ap); unsigned char* ws = ap->ws; unsigned char* wl = ws + WS_W + (size_t)L * LAYER_W;
            pg8::Gemm g{(const bf16_t*)(ws + WS_MERGED), (const bf16_t*)(wl + OFF_WOUT), D, D, D, 0};
            int bxl = blockIdx.x; asm volatile("" : "+s"(bxl)); pg8::StaticOrder S; S.init(M, D, GRID, bxl);
            pg8::EpiRes E{(L == 0) ? ap->in[0] : (const float*)ap->out, ap->out, (bf16_t*)(ws + WS_XB), (float*)(ws + WS_SSQ), lds};
            pg8::gemm_phase<pg8::EpiRes, false>(lds, g, S, E, wv);
        }
        GRID_BAR();
        {
            KARGS(ap); unsigned char* ws = ap->ws; unsigned char* wl = ws + WS_W + (size_t)L * LAYER_W;
            pg8::Gemm g{(const bf16_t*)(ws + WS_XB), (const bf16_t*)(wl + OFF_WFF), D, D, D, 0};
            int bxl = blockIdx.x; asm volatile("" : "+s"(bxl)); pg8::StaticOrder S; S.init(M, NFF2, GRID, bxl);
            pg8::EpiSwiGLU E{(bf16_t*)(ws + WS_FFACT), xl};
            fill_rstd(xl, (const float*)(ws + WS_SSQ), S, (wv << 6) | lane_id());
            pg8::gemm_phase<pg8::EpiSwiGLU, true>(lds, g, S, E, wv);
        }
        GRID_BAR();
        {
            KARGS(ap); unsigned char* ws = ap->ws; unsigned char* wl = ws + WS_W + (size_t)L * LAYER_W;
            pg8::Gemm g{(const bf16_t*)(ws + WS_FFACT), (const bf16_t*)(wl + OFF_WFO), FF, FF, FF, 0};
            int bxl = blockIdx.x; asm volatile("" : "+s"(bxl)); pg8::StaticOrder S; S.init(M, D, GRID, bxl);
            pg8::EpiRes E{(const float*)ap->out, ap->out, (bf16_t*)(ws + WS_XB), (float*)(ws + WS_SSQ), lds};
            pg8::gemm_phase<pg8::EpiRes, false>(lds, g, S, E, wv);
        }
        if (L + 1 < DEPTH) GRID_BAR();
    }
}

extern "C" void kernel_launch(void* const* d_in, const int* in_sizes, int n_in, void* d_out, int out_size, void* d_ws, size_t ws_size, hipStream_t stream) {
    static int ready = 0;
    if (ready == 0) {
        if (n_in != 16 || in_sizes[0] != M * D || out_size != M * D || ws_size < WS_END) {
            fprintf(stderr, "kernel_launch: unexpected shapes (n_in %d, in0 %d, out %d, ws %zu < %zu); nothing launched\n", n_in, n_in > 0 ? in_sizes[0] : -1, out_size, ws_size, (size_t)WS_END); ready = -1; return; }
        if (hipFuncSetAttribute((const void*)fwd_megakernel, hipFuncAttributeMaxDynamicSharedMemorySize, LDS_BYTES) != hipSuccess) { fprintf(stderr, "kernel_launch: hipFuncSetAttribute failed\n"); ready = -1; return; }
        int dev = 0, cus = 0, per_cu = 0;
        (void)hipGetDevice(&dev); (void)hipDeviceGetAttribute(&cus, hipDeviceAttributeMultiprocessorCount, dev);
        (void)hipOccupancyMaxActiveBlocksPerMultiprocessor(&per_cu, (const void*)fwd_megakernel, NTHREADS, LDS_BYTES);
        if (cus * per_cu < GRID) fprintf(stderr, "kernel_launch: note: %d CUs x %d blocks/CU < grid %d\n", cus, per_cu, GRID);
        (void)hipGetLastError();
        ready = 1;
    }
    if (ready < 0) return;
    if (hipMemsetAsync((char*)d_ws + WS_BAR, 0, WS_BAR_BYTES, stream) != hipSuccess) { fprintf(stderr, "kernel_launch: hipMemsetAsync failed\n"); return; }
    Args a{};
    for (int i = 0; i < 16; ++i) a.in[i] = (const float*)d_in[i];
    a.out = (float*)d_out; a.ws = (unsigned char*)d_ws;
    for (int j = 0; j < 16; ++j) a.invf[j] = (float)pow(500000.0, -(double)j / 16.0);
    void* kargs[] = {&a};
    hipError_t e = hipLaunchCooperativeKernel((const void*)fwd_megakernel, dim3(GRID), dim3(NTHREADS), kargs, LDS_BYTES, stream);
    if (e != hipSuccess) fprintf(stderr, "kernel_launch: cooperative launch failed: %s\n", hipGetErrorString(e));
}
```

```cpp
#include <hip/hip_runtime.h>
#include <hip/hip_cooperative_groups.h>
#include <cstdio>
#include <cstdint>
#include <cmath>
namespace cg = cooperative_groups;

#define LAS __attribute__((address_space(3)))
typedef unsigned short bf16_t;
typedef short bf16x8 __attribute__((ext_vector_type(8)));
typedef float f32x4 __attribute__((ext_vector_type(4)));
typedef float f32x16 __attribute__((ext_vector_type(16)));
typedef unsigned u32x4 __attribute__((ext_vector_type(4)));
typedef unsigned u32x2 __attribute__((ext_vector_type(2)));

constexpr int M = 16384, D = 1024, NIN = 6144, FF = 2816, NFF2 = 5632, DEPTH = 4;
constexpr float NORM_EPS = 1e-6f;
constexpr float QSC = 0.08838834764831845f * 1.4426950408889634f;
constexpr size_t ACT_ELEMS = (size_t)M * D;

constexpr size_t MiB = 1u << 20;
constexpr size_t SZ_WIN = (size_t)NIN * D * 2, SZ_WOUT = (size_t)D * D * 2, SZ_WFF = (size_t)NFF2 * D * 2, SZ_WFO = (size_t)D * FF * 2, SZ_POOL = 4 * 256 * 256 * 2;
constexpr size_t OFF_WIN = 0, OFF_WOUT = OFF_WIN + SZ_WIN, OFF_WFF = OFF_WOUT + SZ_WOUT, OFF_WFO = OFF_WFF + SZ_WFF, OFF_POOL = OFF_WFO + SZ_WFO, LAYER_W = OFF_POOL + SZ_POOL;
static_assert(LAYER_W == 31 * MiB, "weights per layer");
constexpr size_t WS_W = 0;
constexpr size_t WS_ACT = 124 * MiB;
constexpr size_t WS_ATTN = WS_ACT + 6 * 32 * MiB;
constexpr size_t WS_XB = WS_ATTN + 32 * MiB;
constexpr size_t WS_SSQ = WS_XB + 32 * MiB;
constexpr size_t WS_COS = WS_SSQ + 4 * M * 4;
constexpr size_t WS_SIN = WS_COS + (size_t)M * 16 * 4;
constexpr size_t WS_BAR = WS_SIN + (size_t)M * 16 * 4;
constexpr size_t WS_BAR_BYTES = 16384;
constexpr size_t WS_END = WS_BAR + WS_BAR_BYTES;
constexpr size_t WS_FFACT = WS_ACT;
constexpr size_t WS_MERGED = WS_ACT + 32 * MiB;
constexpr size_t WS_POOLED = WS_ACT + 64 * MiB;
static_assert((size_t)M * FF * 2 <= 96 * MiB, "ffn activation overlay");

constexpr int RING_BYTES = 131072, XL_OFF = RING_BYTES, XL_BYTES = 8192, LDS_BYTES = 163840;
constexpr int NWAVES = 8, NTHREADS = 512, GRID = 256;

__device__ __forceinline__ unsigned cvt_pk_bf16(float lo, float hi) { unsigned r; asm volatile("v_cvt_pk_bf16_f32 %0, %1, %2" : "=v"(r) : "v"(lo), "v"(hi)); return r; }
__device__ __forceinline__ float bf_lo(unsigned w) { return __uint_as_float(w << 16); }
__device__ __forceinline__ float bf_hi(unsigned w) { return __uint_as_float(w & 0xffff0000u); }
__device__ __forceinline__ u32x4 pack8(const f32x4 a, const f32x4 b) { u32x4 w; w.x = cvt_pk_bf16(a[0], a[1]); w.y = cvt_pk_bf16(a[2], a[3]); w.z = cvt_pk_bf16(b[0], b[1]); w.w = cvt_pk_bf16(b[2], b[3]); return w; }
__device__ __forceinline__ void unpack8(const u32x4 w, f32x4& a, f32x4& b) { a = (f32x4){bf_lo(w.x), bf_hi(w.x), bf_lo(w.y), bf_hi(w.y)}; b = (f32x4){bf_lo(w.z), bf_hi(w.z), bf_lo(w.w), bf_hi(w.w)}; }
__device__ __forceinline__ float sigmoidf_(float x) { return __builtin_amdgcn_rcpf(1.0f + __builtin_amdgcn_exp2f(-1.4426950408889634f * x)); }
__device__ __forceinline__ int lane_id() { int r; asm volatile("v_mbcnt_lo_u32_b32 %0, -1, 0\n\tv_mbcnt_hi_u32_b32 %0, -1, %0" : "=v"(r)); return r; }
#define XB_TMO      128
#define XB_XCNT(j)  (256  + 64 * (j))
#define XB_XSUB(j)  (1280 + 64 * (j))
#define XB_XGEN(j)  (2304 + 64 * (j))
#define XB_TOP      3328
#define XB_TOPGEN   3392
#define XCD_BAR_WORDS 3456
#define XB_SPIN_CAP (1u << 22)
__device__ __forceinline__ unsigned xb_ld(unsigned* p)              { return __hip_atomic_load(p, __ATOMIC_RELAXED, __HIP_MEMORY_SCOPE_AGENT); }
__device__ __forceinline__ unsigned xb_add(unsigned* p, unsigned v) { return __hip_atomic_fetch_add(p, v, __ATOMIC_RELAXED, __HIP_MEMORY_SCOPE_AGENT); }
__device__ __forceinline__ unsigned xb_xcc_id() { return (unsigned)__builtin_amdgcn_s_getreg((3 << 11) | 20) & 0xFu; }
#define XB_SPIN(cond, bar) do { unsigned _sp = 0; while (cond) { __builtin_amdgcn_s_sleep(1); \
    if ((++_sp & 255u) == 0u) { if (xb_ld(&(bar)[XB_TMO])) break; if (_sp > XB_SPIN_CAP) { atomicAdd(&(bar)[XB_TMO], 1u); break; } } } } while (0)
__device__ __forceinline__ void xcd_barrier_complete(unsigned* bar, unsigned x, unsigned& nloc, unsigned& nx) {
    const unsigned G = gridDim.x;
    unsigned sum, cnt, mine, sp = 0u;
    for (;;) {
        sum = 0u; cnt = 0u; mine = 0u;
#pragma unroll
        for (unsigned j = 0; j < 16; ++j) { const unsigned c = xb_ld(&bar[XB_XCNT(j)]); sum += c; cnt += (c > 0u) ? 1u : 0u; mine = (j == x) ? c : mine; }
        if (sum == G) break;
        __builtin_amdgcn_s_sleep(1);
        if ((++sp & 255u) == 0u) { if (xb_ld(&bar[XB_TMO])) break; if (sp > XB_SPIN_CAP) { atomicAdd(&bar[XB_TMO], 1u); break; } }
    }
    nloc = mine > 0u ? mine : 1u; nx = cnt > 0u ? cnt : 1u;
}
__device__ __forceinline__ void grid_barrier(unsigned* bar, volatile LAS unsigned* st, int wv) {
    asm volatile("s_waitcnt vmcnt(0) lgkmcnt(0)" ::: "memory");
    __syncthreads();
    if (wv == 0) {
        if (lane_id() == 0) {
            const unsigned x = xb_xcc_id();
            unsigned nloc = st[0], nx = st[1];
            if (nloc == 0u) { xcd_barrier_complete(bar, x, nloc, nx); st[0] = nloc; st[1] = nx; }
            const unsigned old = xb_add(&bar[XB_XSUB(x)], 1u);
            const unsigned gen = old / nloc;
            if (old + 1u == (gen + 1u) * nloc) {
                __builtin_amdgcn_fence(__ATOMIC_RELEASE, "agent");
                asm volatile("s_waitcnt vmcnt(0)" ::: "memory");
                const unsigned og = xb_add(&bar[XB_TOP], 1u);
                const unsigned tg = og / nx;
                if (og + 1u == (tg + 1u) * nx) xb_add(&bar[XB_TOPGEN], 1u);
                else XB_SPIN(xb_ld(&bar[XB_TOPGEN]) == tg, bar);
                __builtin_amdgcn_fence(__ATOMIC_ACQUIRE, "agent");
                xb_add(&bar[XB_XGEN(x)], 1u);
                asm volatile("s_waitcnt vmcnt(0)" ::: "memory");
            } else {
                XB_SPIN(xb_ld(&bar[XB_XGEN(x)]) == gen, bar);
                __builtin_amdgcn_fence(__ATOMIC_ACQUIRE, "agent");
                asm volatile("s_waitcnt vmcnt(0)" ::: "memory");
            }
        }
    }
    __syncthreads();
}
__device__ __forceinline__ float xor32_sum(float v) { auto rr = __builtin_amdgcn_permlane32_swap(__float_as_uint(v), __float_as_uint(v), false, false); return __uint_as_float(rr[0]) + __uint_as_float(rr[1]); }
__device__ __forceinline__ float xor32_get(float v, int hi) { auto rr = __builtin_amdgcn_permlane32_swap(__float_as_uint(v), __float_as_uint(v), false, false); return hi ? __uint_as_float(rr[0]) : __uint_as_float(rr[1]); }
__device__ __forceinline__ float xor16_sum(float v) { return v + __uint_as_float((unsigned)__builtin_amdgcn_ds_swizzle((int)__float_as_uint(v), 0x401F)); }
__device__ __forceinline__ float wave_sum_rl(float v) { float s = 0.f;
#pragma unroll
    for (int i = 0; i < 64; ++i) s += __uint_as_float((unsigned)__builtin_amdgcn_readlane((int)__float_as_uint(v), i));
    return s; }
__device__ __forceinline__ float wave_max_rl(float v) { float s = 0.f;
#pragma unroll
    for (int i = 0; i < 64; ++i) s = fmaxf(s, __uint_as_float((unsigned)__builtin_amdgcn_readlane((int)__float_as_uint(v), i)));
    return s; }
#define LDS_BAR() do { asm volatile("s_waitcnt lgkmcnt(0)" ::: "memory"); __builtin_amdgcn_s_barrier(); asm volatile("" ::: "memory"); } while (0)

namespace pg8 {
constexpr int BM = 256, BK = 64, HALF = 128, HTB = HALF * BK * 2, NXCD = 8, WGM = 8;
__device__ __forceinline__ int lds_byte(int r, int c) { const int st = (r >> 4) * 2 + (c >> 5), rr = r & 15, cc = c & 31, ob = rr * 64 + cc * 2; return st * 1024 + (ob ^ (((ob >> 9) & 1) << 5)); }
__device__ __forceinline__ void stage_rc(int b, int& R, int& C) { const int st = b / 1024, sb = b % 1024, swz = sb ^ (((sb >> 9) & 1) << 5); R = (st >> 1) * 16 + swz / 64; C = (st & 1) * 32 + (swz % 64) / 2; }
__device__ __forceinline__ int perm32(int rho) { const int n = rho >> 4, i = rho & 15; return 8 * (i >> 2) + 4 * n + (i & 3); }

struct Unit { int pm, pn; };
struct Gemm { const bf16_t* A; const bf16_t* Bt; int lda, ldb, K, a_cpn; };

struct StaticOrder {
    int nM, nN, nwg, G, c;
    __device__ void init(int M_, int N_, int G_, int c_) { nM = M_ / BM; nN = N_ / BM; nwg = nM * nN; G = G_; c = c_; }
    __device__ bool next(int i, Unit& u) const {
        const long L = (long)i * G + c; if (L >= nwg) return false;
        int wgid = (int)L; { const int q = nwg / NXCD, r = nwg % NXCD, xcd = wgid % NXCD, off = wgid / NXCD; wgid = (xcd < r ? xcd * (q + 1) : r * (q + 1) + (xcd - r) * q) + off; }
        const int nig = WGM * nN, gid = wgid / nig, fm = gid * WGM, gsz = (nM - fm) < WGM ? (nM - fm) : WGM;
        u.pm = fm + ((wgid % nig) % gsz); u.pn = (wgid % nig) / gsz; return true;
    }
};


struct EpiIn {
    static constexpr bool PERM = true, AFTER_DRAIN = false;
    unsigned char* ws; const float* gq; const float* gk; LAS float* xl;
    __device__ __forceinline__ void operator()(f32x4 (&acc)[2][2][4][2], const Unit& u, int wr, int wc, int fr, int fq, int wid, int lane, int ui) const {
        bf16_t* out0 = (bf16_t*)(ws + WS_ACT); const float* rcos = (const float*)(ws + WS_COS); const float* rsin = (const float*)(ws + WS_SIN);
        const LAS float* rsl = xl + XL_BYTES / 4 + ui * 256;
        const int kind = u.pn >> 2, cb = (u.pn & 3) * 256;
        bf16_t* dst = out0 + (size_t)kind * ACT_ELEMS;
        const int row0 = u.pm * BM + wr * 64 + fr, colw = wc * 32 + 8 * fq;
#pragma unroll
        for (int ai = 0; ai < 2; ++ai)
#pragma unroll
            for (int m = 0; m < 4; ++m) {
                const float rs = rsl[ai * HALF + wr * 64 + m * 16 + fr];
#pragma unroll
                for (int bj = 0; bj < 2; ++bj)
#pragma unroll
                    for (int n = 0; n < 2; ++n) acc[ai][bj][m][n] *= rs;
                if (m & 1) __builtin_amdgcn_sched_barrier(0);
            }
        if (kind == 1 || kind == 2) {
            const float* g = (kind == 1) ? gq : gk;
#pragma unroll
            for (int ai = 0; ai < 2; ++ai)
#pragma unroll
                for (int m = 0; m < 4; ++m)
#pragma unroll
                    for (int bj = 0; bj < 2; ++bj) {
                        const f32x4 a = acc[ai][bj][m][0], b = acc[ai][bj][m][1];
                        float ss = (a[0] * a[0] + a[1] * a[1]) + (a[2] * a[2] + a[3] * a[3]) + (b[0] * b[0] + b[1] * b[1]) + (b[2] * b[2] + b[3] * b[3]);
                        ss = xor32_sum(xor16_sum(ss));
                        if (fq == 0) xl[((ai * HALF + wr * 64 + m * 16 + fr) * 2 + bj) * 4 + wc] = ss;
                    }
            LDS_BAR();
            const f32x4 g0 = *(const f32x4*)(g + colw), g1 = *(const f32x4*)(g + colw + 4);
            const float osc = (kind == 1) ? QSC : 1.0f;
            const float sgn = (fq < 2) ? -1.0f : 1.0f;
#pragma unroll
            for (int ai = 0; ai < 2; ++ai)
#pragma unroll
                for (int m = 0; m < 4; ++m) {
                    const int rt = ai * HALF + wr * 64 + m * 16 + fr, r = u.pm * BM + rt;
                    f32x4 c0, c1, s0, s1;
                    if (wc == 0) { const int j0 = 8 * (fq & 1); c0 = *(const f32x4*)(rcos + (size_t)r * 16 + j0); c1 = *(const f32x4*)(rcos + (size_t)r * 16 + j0 + 4);
                                   s0 = *(const f32x4*)(rsin + (size_t)r * 16 + j0); s1 = *(const f32x4*)(rsin + (size_t)r * 16 + j0 + 4); }
#pragma unroll
                    for (int bj = 0; bj < 2; ++bj) {
                        const f32x4 t4 = *(const LAS f32x4*)(xl + (rt * 2 + bj) * 4);
                        const float rn = __builtin_amdgcn_rsqf(((t4[0] + t4[1]) + (t4[2] + t4[3])) * (1.0f / 128.0f) + NORM_EPS);
                        f32x4 v0 = acc[ai][bj][m][0] * rn * g0, v1 = acc[ai][bj][m][1] * rn * g1;
                        if (wc == 0) {
                            f32x4 p0, p1;
#pragma unroll
                            for (int i = 0; i < 4; ++i) { p0[i] = xor32_get(v0[i], fq >> 1); p1[i] = xor32_get(v1[i], fq >> 1); }
                            v0 = v0 * c0 + (p0 * s0) * sgn; v1 = v1 * c1 + (p1 * s1) * sgn;
                        }
                        v0 *= osc; v1 *= osc;
                        *(u32x4*)(dst + (size_t)r * D + cb + bj * HALF + colw) = pack8(v0, v1);
                    }
                    __builtin_amdgcn_sched_barrier(0);
                }
        } else {
            const bool sg = kind >= 4;
#pragma unroll
            for (int ai = 0; ai < 2; ++ai)
#pragma unroll
                for (int m = 0; m < 4; ++m) {
                    const int r = row0 + ai * HALF + m * 16;
#pragma unroll
                    for (int bj = 0; bj < 2; ++bj) {
                        f32x4 v0 = acc[ai][bj][m][0], v1 = acc[ai][bj][m][1];
                        if (sg) {
#pragma unroll
                            for (int i = 0; i < 4; ++i) { v0[i] = sigmoidf_(v0[i]); v1[i] = sigmoidf_(v1[i]); }
                        }
                        *(u32x4*)(dst + (size_t)r * D + cb + bj * HALF + colw) = pack8(v0, v1);
                    }
                }
        }
    }
};

struct EpiSwiGLU {
    static constexpr bool PERM = true, AFTER_DRAIN = false;
    bf16_t* act; LAS float* xl;
    __device__ __forceinline__ void operator()(f32x4 (&acc)[2][2][4][2], const Unit& u, int wr, int wc, int fr, int fq, int wid, int lane, int ui) const {
        const int row0 = u.pm * BM + wr * 64 + fr, col = u.pn * HALF + wc * 32 + 8 * fq;
#pragma unroll
        for (int ai = 0; ai < 2; ++ai)
#pragma unroll
            for (int m = 0; m < 4; ++m) {
                const int r = row0 + ai * HALF + m * 16;
                const float rs = xl[XL_BYTES / 4 + ui * 256 + ai * HALF + wr * 64 + m * 16 + fr];
                f32x4 o[2];
#pragma unroll
                for (int n = 0; n < 2; ++n) {
                    const f32x4 gt = acc[ai][0][m][n] * rs, up = acc[ai][1][m][n] * rs;
#pragma unroll
                    for (int i = 0; i < 4; ++i) o[n][i] = gt[i] * sigmoidf_(gt[i]) * up[i];
                }
                *(u32x4*)(act + (size_t)r * FF + col) = pack8(o[0], o[1]);
            }
    }
};

struct EpiMerge {
    static constexpr bool PERM = true, AFTER_DRAIN = true;
    const bf16_t* sga; const bf16_t* sgb; const bf16_t* o0; const bf16_t* o1; const float* pscale; const float* subg; bf16_t* merged; float osc; LAS float* xl;
    __device__ __forceinline__ void operator()(f32x4 (&acc)[2][2][4][2], const Unit& u, int wr, int wc, int fr, int fq, int wid, int lane, int ui) const {
        const int row0 = u.pm * BM + wr * 64 + fr;
#pragma unroll
        for (int ai = 0; ai < 2; ++ai)
#pragma unroll
            for (int m = 0; m < 4; ++m) {
                float ss = 0.f;
#pragma unroll
                for (int bj = 0; bj < 2; ++bj) {
                    const size_t off = (size_t)(row0 + ai * HALF + m * 16) * D + u.pn * BM + bj * HALF + wc * 32 + 8 * fq;
                    f32x4 a0, a1, b0, b1; unpack8(*(const u32x4*)(o0 + off), a0, a1); unpack8(*(const u32x4*)(o1 + off), b0, b1);
                    const f32x4 d0 = a0 - b0, d1 = a1 - b1;
                    ss += (d0[0] * d0[0] + d0[1] * d0[1]) + (d0[2] * d0[2] + d0[3] * d0[3]) + (d1[0] * d1[0] + d1[1] * d1[1]) + (d1[2] * d1[2] + d1[3] * d1[3]);
                }
                ss = xor32_sum(xor16_sum(ss));
                if (fq == 0) xl[(ai * HALF + wr * 64 + m * 16 + fr) * 4 + wc] = ss;
            }
        LDS_BAR();
#pragma unroll
        for (int bj = 0; bj < 2; ++bj) {
            const int col = u.pn * BM + bj * HALF + wc * 32 + 8 * fq;
            const f32x4 ps0 = *(const f32x4*)(pscale + col), ps1 = *(const f32x4*)(pscale + col + 4);
            const f32x4 g0 = *(const f32x4*)(subg + (col & 255)), g1 = *(const f32x4*)(subg + (col & 255) + 4);
#pragma unroll
            for (int ai = 0; ai < 2; ++ai)
#pragma unroll
                for (int m = 0; m < 4; ++m) {
                    const int rt = ai * HALF + wr * 64 + m * 16 + fr;
                    const f32x4 t4 = *(const LAS f32x4*)(xl + rt * 4);
                    const float rn = __builtin_amdgcn_rsqf(((t4[0] + t4[1]) + (t4[2] + t4[3])) * (1.0f / 256.0f) + NORM_EPS) * osc;
                    const size_t off = (size_t)(u.pm * BM + rt) * D + col;
                    const u32x4 wa = *(const u32x4*)(sga + off), wb = *(const u32x4*)(sgb + off), w0 = *(const u32x4*)(o0 + off), w1 = *(const u32x4*)(o1 + off);
                    f32x4 a0, a1, b0, b1, x0, x1, y0, y1; unpack8(wa, a0, a1); unpack8(wb, b0, b1); unpack8(w0, x0, x1); unpack8(w1, y0, y1);
                    const f32x4 t0 = (x0 - y0) * g0 * rn, t1 = (x1 - y1) * g1 * rn;
                    const f32x4 r0 = a0 * (acc[ai][bj][m][0] * ps0) + b0 * t0, r1 = a1 * (acc[ai][bj][m][1] * ps1) + b1 * t1;
                    *(u32x4*)(merged + off) = pack8(r0, r1);
                }
        }
        LDS_BAR();
    }
};

__device__ __forceinline__ float swz_sum32(float v) {
    v += __uint_as_float((unsigned)__builtin_amdgcn_ds_swizzle((int)__float_as_uint(v), 0x041F));
    v += __uint_as_float((unsigned)__builtin_amdgcn_ds_swizzle((int)__float_as_uint(v), 0x081F));
    v += __uint_as_float((unsigned)__builtin_amdgcn_ds_swizzle((int)__float_as_uint(v), 0x101F));
    v += __uint_as_float((unsigned)__builtin_amdgcn_ds_swizzle((int)__float_as_uint(v), 0x201F));
    v += __uint_as_float((unsigned)__builtin_amdgcn_ds_swizzle((int)__float_as_uint(v), 0x401F));
    return v;
}
struct EpiRes {
    static constexpr bool PERM = false, AFTER_DRAIN = true;
    const float* res; float* out; bf16_t* xb; float* ssq; LAS unsigned char* lds;
    __device__ __forceinline__ void operator()(f32x4 (&acc)[2][2][4][2], const Unit& u, int wr, int wc, int fr, int fq, int wid, int lane, int ui) const {
        constexpr int RS = 1040;
#pragma unroll
        for (int ai = 0; ai < 2; ++ai) {
#pragma unroll
            for (int m = 0; m < 4; ++m)
#pragma unroll
                for (int bj = 0; bj < 2; ++bj)
#pragma unroll
                    for (int n = 0; n < 2; ++n)
                        *(LAS f32x4*)(lds + (wr * 64 + m * 16 + fr) * RS + (bj * HALF + wc * 32 + n * 16 + 4 * fq) * 4) = acc[ai][bj][m][n];
            LDS_BAR();
#pragma unroll 1
            for (int c = 0; c < 2; ++c) {
                f32x4 rv[8];
#pragma unroll
                for (int rr = 0; rr < 8; ++rr) { const size_t grow = (size_t)(u.pm * BM + ai * HALF + wid * 16 + c * 8 + rr); rv[rr] = *((const f32x4*)(res + grow * D + u.pn * BM) + lane); }
#pragma unroll
                for (int rr = 0; rr < 8; ++rr) {
                    const int rl = wid * 16 + c * 8 + rr; const size_t grow = (size_t)(u.pm * BM + ai * HALF + rl);
                    const f32x4 v = rv[rr] + *(const LAS f32x4*)(lds + rl * RS + lane * 16);
                    *((f32x4*)(out + grow * D + u.pn * BM) + lane) = v;
                    u32x2 w; w.x = cvt_pk_bf16(v[0], v[1]); w.y = cvt_pk_bf16(v[2], v[3]);
                    *((u32x2*)(xb + grow * D + u.pn * BM) + lane) = w;
                    float ss = (v[0] * v[0] + v[1] * v[1]) + (v[2] * v[2] + v[3] * v[3]);
                    ss = xor32_sum(swz_sum32(ss));
                    if (lane == 0) ssq[(size_t)u.pn * M + grow] = ss;
                }
            }
            LDS_BAR();
        }
    }
};

template <class Epi, bool ALIGN_EPI>
__device__ __forceinline__ void gemm_phase(LAS unsigned char* lds, const Gemm g, const StaticOrder& S, const Epi& E, int wv) {
    int tid_ = (wv << 6) | lane_id(); asm volatile("" : "+v"(tid_));
    const int tid = tid_, wid = __builtin_amdgcn_readfirstlane(tid >> 6), lane = tid & 63, wr = wid >> 2, wc = wid & 3, fr = lane & 15, fq = lane >> 4;
    const int K = g.K, nt = K / BK;
    unsigned voffA[2], voffB[2];
#pragma unroll
    for (int i = 0; i < 2; ++i) { int R, C; stage_rc(tid * 16 + i * 8192, R, C); const int Rb = Epi::PERM ? ((R & ~31) + perm32(R & 31)) : R;
        voffA[i] = (unsigned)(R * g.lda + C) * 2u; voffB[i] = (unsigned)(Rb * g.ldb + C) * 2u; }
    const size_t kstep = (size_t)(BK * 2);
    const size_t hstepA = (size_t)HALF * g.lda * 2, hstepB = (size_t)HALF * g.ldb * 2;
    const unsigned ldsw = (unsigned)wid * 1024u;
    const int aoff = lds_byte(wr * 64 + fr, fq * 8), boff = lds_byte(wc * 32 + fr, fq * 8);
#define PG8_SA(b, h) (((b) * 2 + (h)) * HTB)
#define PG8_SB(b, h) ((4 + (b) * 2 + (h)) * HTB)
#define PG8_STAGE(bufoff, gbase, voff) do { _Pragma("unroll") for (int _i = 0; _i < 2; ++_i) \
        __builtin_amdgcn_global_load_lds((const unsigned*)((const char*)(gbase) + (voff)[_i]), (LAS unsigned*)(lds + (bufoff) + ldsw + _i * 8192), 16, 0, 0); } while (0)
#define PG8_LDA(dst, b, h) do { _Pragma("unroll") for (int m = 0; m < 4; ++m) _Pragma("unroll") for (int k = 0; k < 2; ++k) dst[m][k] = *(const LAS bf16x8*)(lds + PG8_SA(b, h) + aoff + m * 2048 + k * 1024); } while (0)
#define PG8_LDB(dst, b, h) do { _Pragma("unroll") for (int n = 0; n < 2; ++n) _Pragma("unroll") for (int k = 0; k < 2; ++k) dst[n][k] = *(const LAS bf16x8*)(lds + PG8_SB(b, h) + boff + n * 2048 + k * 1024); } while (0)
#define PG8_MMA(ai, bj, At, Bt) do { __builtin_amdgcn_s_setprio(1); _Pragma("unroll") for (int m = 0; m < 4; ++m) _Pragma("unroll") for (int n = 0; n < 2; ++n) _Pragma("unroll") for (int k = 0; k < 2; ++k) \
        acc[ai][bj][m][n] = __builtin_amdgcn_mfma_f32_16x16x32_bf16(Bt[n][k], At[m][k], acc[ai][bj][m][n], 0, 0, 0); __builtin_amdgcn_s_setprio(0); } while (0)
#define PG8_WAIT_V(n) asm volatile("s_waitcnt vmcnt(" #n ")" ::: "memory")
#define PG8_WAIT_L(n) asm volatile("s_waitcnt lgkmcnt(" #n ")" ::: "memory")
#define PG8_BAR __builtin_amdgcn_s_barrier()
#define PG8_SCHED __builtin_amdgcn_sched_barrier(0)
#define PG8_UA(u_) ((const char*)g.A + ((size_t)(u_).pm * BM * g.lda + (size_t)(u_).pn * g.a_cpn) * 2)
#define PG8_UB(u_) ((const char*)g.Bt + (size_t)(u_).pn * BM * g.ldb * 2)
    Unit cur, nxt; int ui = 0;
    (void)S.next(0, cur);
    f32x4 acc[2][2][4][2];
#pragma unroll
    for (int a = 0; a < 2; ++a)
#pragma unroll
        for (int b = 0; b < 2; ++b)
#pragma unroll
            for (int m = 0; m < 4; ++m)
#pragma unroll
                for (int n = 0; n < 2; ++n) acc[a][b][m][n] = (f32x4){0.f, 0.f, 0.f, 0.f};
    bf16x8 At[4][2], B0[2][2], B1[2][2];
    const char* cA = PG8_UA(cur); const char* cB = PG8_UB(cur);
    PG8_STAGE(PG8_SB(0, 0), cB, voffB); PG8_STAGE(PG8_SB(0, 1), cB + hstepB, voffB); PG8_STAGE(PG8_SA(0, 0), cA, voffA); PG8_STAGE(PG8_SA(0, 1), cA + hstepA, voffA);
    if (wr == 1) PG8_BAR;
    PG8_WAIT_V(2); PG8_BAR;
    PG8_STAGE(PG8_SB(1, 0), cB + kstep, voffB); PG8_STAGE(PG8_SA(1, 0), cA + kstep, voffA); PG8_STAGE(PG8_SB(1, 1), cB + hstepB + kstep, voffB);
    PG8_WAIT_V(6); PG8_BAR;
    for (;;) {
        const bool has_next = S.next(ui + 1, nxt);
        const char* nA = has_next ? PG8_UA(nxt) : cA; const char* nB = has_next ? PG8_UB(nxt) : cB;
        for (int t = 0; t < nt; t += 2) {
            const bool last = (t == nt - 2);
            const char* a1 = cA + (size_t)(t + 1) * kstep;
            const char* a2 = last ? nA : cA + (size_t)(t + 2) * kstep; const char* b2 = last ? nB : cB + (size_t)(t + 2) * kstep;
            const char* a3 = a2 + kstep; const char* b3 = b2 + kstep;
            PG8_LDB(B0, 0, 0); PG8_LDB(B1, 0, 1); PG8_SCHED; PG8_LDA(At, 0, 0); PG8_STAGE(PG8_SA(1, 1), a1 + hstepA, voffA);
            PG8_WAIT_V(8); PG8_WAIT_L(0); PG8_BAR; PG8_MMA(0, 0, At, B0); PG8_MMA(0, 1, At, B1); PG8_BAR; PG8_SCHED;
            PG8_LDA(At, 0, 1); PG8_STAGE(PG8_SB(0, 0), b2, voffB); PG8_STAGE(PG8_SB(0, 1), b2 + hstepB, voffB); PG8_STAGE(PG8_SA(0, 0), a2, voffA);
            PG8_WAIT_V(8); PG8_WAIT_L(0); PG8_BAR; PG8_MMA(1, 0, At, B0); PG8_MMA(1, 1, At, B1); PG8_BAR; PG8_SCHED;
            PG8_LDB(B0, 1, 0); PG8_LDB(B1, 1, 1); PG8_SCHED; PG8_LDA(At, 1, 0); PG8_STAGE(PG8_SA(0, 1), a2 + hstepA, voffA);
            PG8_WAIT_V(8); PG8_WAIT_L(0); PG8_BAR; PG8_MMA(0, 0, At, B0); PG8_MMA(0, 1, At, B1); PG8_BAR; PG8_SCHED;
            PG8_LDA(At, 1, 1); PG8_STAGE(PG8_SB(1, 0), b3, voffB); PG8_STAGE(PG8_SB(1, 1), b3 + hstepB, voffB); PG8_STAGE(PG8_SA(1, 0), a3, voffA);
            PG8_WAIT_V(8); PG8_WAIT_L(0); PG8_BAR; PG8_MMA(1, 0, At, B0); PG8_MMA(1, 1, At, B1); PG8_BAR; PG8_SCHED;
        }
        if constexpr (ALIGN_EPI) { if (wr == 0) PG8_BAR; }
        if constexpr (!Epi::AFTER_DRAIN) { E(acc, cur, wr, wc, fr, fq, wid, lane, ui); }
        if (!has_next) break;
#pragma unroll
        for (int a = 0; a < 2; ++a)
#pragma unroll
            for (int b = 0; b < 2; ++b)
#pragma unroll
                for (int m = 0; m < 4; ++m)
#pragma unroll
                    for (int n = 0; n < 2; ++n) acc[a][b][m][n] = (f32x4){0.f, 0.f, 0.f, 0.f};
        cur = nxt; cA = nA; cB = nB; ++ui;
        if constexpr (ALIGN_EPI) { if (wr == 1) PG8_BAR; }
    }
    PG8_WAIT_V(0);
    if constexpr (!ALIGN_EPI) { if (wr == 0) PG8_BAR; }
    PG8_BAR;
    if constexpr (Epi::AFTER_DRAIN) { E(acc, cur, wr, wc, fr, fq, wid, lane, ui); }
#undef PG8_SA
#undef PG8_SB
#undef PG8_STAGE
#undef PG8_LDA
#undef PG8_LDB
#undef PG8_MMA
#undef PG8_WAIT_V
#undef PG8_WAIT_L
#undef PG8_BAR
#undef PG8_SCHED
#undef PG8_UA
#undef PG8_UB
}
}

namespace att {
typedef LAS const char* lds_cptr;
typedef short v4i16_t __attribute__((ext_vector_type(4)));
constexpr int STAGE = 65536, KV = 64;
__device__ __forceinline__ void glds16(const void* gsrc, unsigned lds_dst) { unsigned keep;
    asm volatile("s_mov_b32 %0, m0\n\ts_mov_b32 m0, %2\n\ts_nop 0\n\tglobal_load_lds_dwordx4 %1, off\n\ts_mov_b32 m0, %0" : "=&s"(keep) : "v"(gsrc), "s"(lds_dst) : "memory"); }
__device__ __forceinline__ v4i16_t vtr(lds_cptr p) { return __builtin_amdgcn_ds_read_tr16_b64_v4i16((LAS v4i16_t*)p); }
typedef float f32x2_t __attribute__((ext_vector_type(2))); typedef __bf16 bf16x2_t __attribute__((ext_vector_type(2)));
__device__ __forceinline__ unsigned cvtpk_s(float lo, float hi) { f32x2_t v = {lo, hi}; bf16x2_t b = __builtin_convertvector(v, bf16x2_t); return __builtin_bit_cast(unsigned, b); }
#define ATT_WAIT_BAR() asm volatile("s_waitcnt vmcnt(0) lgkmcnt(0)\n\ts_barrier" ::: "memory")

template <int IDX> __device__ __forceinline__ void dma_piece(unsigned kvo, unsigned vvo, const char* kbn, const char* vbn, unsigned kdn, unsigned vdn) {
    unsigned keep, tv;
    if constexpr (IDX < 4) {
        constexpr int dl = (IDX & 1) * 16 + (IDX >> 1) * 256; const unsigned dst = kdn + (IDX & 1) * 0x400 + (IDX >> 1) * 0x4000;
        asm volatile("s_mov_b32 %0, m0\n\ts_mov_b32 m0, %3\n\tv_add_u32 %1, %4, %2\n\ts_nop 0\n\tglobal_load_lds_dwordx4 %1, %5\n\ts_mov_b32 m0, %0"
                     : "=&s"(keep), "=&v"(tv) : "v"(kvo), "s"(dst), "i"(dl), "s"(kbn) : "memory");
    } else {
        constexpr int dl = (IDX - 4) * 0x8000; const unsigned dst = vdn + (IDX - 4) * 0x400;
        asm volatile("s_mov_b32 %0, m0\n\ts_mov_b32 m0, %3\n\tv_add_u32 %1, %4, %2\n\ts_nop 0\n\tglobal_load_lds_dwordx4 %1, %5\n\ts_mov_b32 m0, %0"
                     : "=&s"(keep), "=&v"(tv) : "v"(vvo), "s"(dst), "i"(dl), "s"(vbn) : "memory");
    }
}
template <bool SHIFT> __device__ __forceinline__ void attn_item(int h, int qb, const bf16_t* Q, const bf16_t* Kt, const bf16_t* V, bf16_t* O, char* shm, float lam, float osc, const float* subg, float cshift, int wv) {
    int tid_ = (wv << 6) | lane_id(); asm volatile("" : "+v"(tid_));
    const int tid = tid_, lane = tid & 63, r32 = lane & 31, hi = lane >> 5;
    const int wid = __builtin_amdgcn_readfirstlane(tid >> 6), comp = wid >> 2, w = wid & 3;
    const int q0 = qb * 128;
    const unsigned lds0 = (unsigned)(uintptr_t)shm;
    const lds_cptr shm3 = (lds_cptr)shm;
    const unsigned kvo = (unsigned)(lane * D + wid * 16) * 2u;
    const unsigned vvo = (unsigned)((lane >> 2) * D + wid * 32 + (lane & 3) * 8) * 2u;
    const char* kbase = (const char*)(Kt + h * 256);
    const char* vbase = (const char*)(V + h * 256);
    const int NT = 2 * qb + 2, NTw = 2 * qb + 1 + (w >> 1);
#define ATT_DMA(t, st) do { const char* kb_ = kbase + (size_t)(t) * (KV * D * 2); const char* vb_ = vbase + (size_t)(t) * (KV * D * 2); \
        const unsigned kd_ = (unsigned)__builtin_amdgcn_readfirstlane(lds0 + (st) + wid * 2048), vd_ = (unsigned)__builtin_amdgcn_readfirstlane(lds0 + (st) + 32768 + wid * 4096); \
        unsigned keep_, tv_; \
        asm volatile("s_nop 4\n\ts_mov_b32 %0, m0\n\ts_mov_b32 m0, %4\n\ts_nop 0\n\t" \
                     "global_load_lds_dwordx4 %2, %6\n\tv_add_u32 %1, 16, %2\n\ts_add_u32 m0, m0, 0x400\n\ts_nop 0\n\t" \
                     "global_load_lds_dwordx4 %1, %6\n\tv_add_u32 %1, 0x100, %2\n\ts_add_u32 m0, m0, 0x3c00\n\ts_nop 0\n\t" \
                     "global_load_lds_dwordx4 %1, %6\n\tv_add_u32 %1, 0x110, %2\n\ts_add_u32 m0, m0, 0x400\n\ts_nop 0\n\t" \
                     "global_load_lds_dwordx4 %1, %6\n\ts_mov_b32 m0, %5\n\ts_nop 0\n\t" \
                     "global_load_lds_dwordx4 %3, %7\n\tv_add_u32 %1, 0x8000, %3\n\ts_add_u32 m0, m0, 0x400\n\ts_nop 0\n\t" \
                     "global_load_lds_dwordx4 %1, %7\n\tv_add_u32 %1, 0x8000, %1\n\ts_add_u32 m0, m0, 0x400\n\ts_nop 0\n\t" \
                     "global_load_lds_dwordx4 %1, %7\n\tv_add_u32 %1, 0x8000, %1\n\ts_add_u32 m0, m0, 0x400\n\ts_nop 0\n\t" \
                     "global_load_lds_dwordx4 %1, %7\n\ts_mov_b32 m0, %0" \
                     : "=&s"(keep_), "=&v"(tv_) : "v"(kvo), "v"(vvo), "s"(kd_), "s"(vd_), "s"(kb_), "s"(vb_) : "memory", "scc"); } while (0)
    ATT_DMA(0, 0);
    bf16x8 qr[8];
    { const bf16_t* qp = Q + (size_t)(q0 + 32 * w + r32) * D + h * 256 + comp * 128 + hi * 8;
#pragma unroll
      for (int ks = 0; ks < 8; ++ks) qr[ks] = *(const bf16x8*)(qp + ks * 16); }
    f32x16 o[8];
#pragma unroll
    for (int d0 = 0; d0 < 8; ++d0) o[d0] = f32x16{};
    float lsum = 0.f;
    const int koff = comp * 16384 + hi * 1024 + r32 * 16;
    const int voff = 32768 + ((r32 >> 4) & 1) * 32 + (r32 & 3) * 8 + (4 * hi + ((r32 & 15) >> 2)) * 64;
#define ATT_SB() __builtin_amdgcn_sched_barrier(0)
    for (int t = 0; t < NT; ++t) {
        const int st = (t & 1) * STAGE;
        ATT_WAIT_BAR();
        const bool has_next = (t + 1 < NT);
        const char* kbn = kbase + (size_t)(t + 1) * (KV * D * 2); const char* vbn = vbase + (size_t)(t + 1) * (KV * D * 2);
        const unsigned kdn = (unsigned)__builtin_amdgcn_readfirstlane(lds0 + (STAGE - st) + wid * 2048), vdn = (unsigned)__builtin_amdgcn_readfirstlane(lds0 + (STAGE - st) + 32768 + wid * 4096);
        if (t >= NTw) { if (has_next) ATT_DMA(t + 1, STAGE - st); }
        if (t < NTw) {
            const lds_cptr kb = shm3 + st + koff;
            const lds_cptr vb = shm3 + st + voff;
#define ATT_KFRAG(i_) (*(const LAS bf16x8*)(kb + ((i_) & 7) * 2048 + ((i_) >> 3) * 512))
#define ATT_VFRAG(dst, j_) do { const v4i16_t lo_ = vtr(vb + ((j_) & 7) * 4096 + ((j_) >> 3) * 1024), hh_ = vtr(vb + ((j_) & 7) * 4096 + ((j_) >> 3) * 1024 + 512); \
        dst = (bf16x8){lo_[0], lo_[1], lo_[2], lo_[3], hh_[0], hh_[1], hh_[2], hh_[3]}; } while (0)
            f32x16 s0, s1;
            u32x4 pw[4];
            bf16x8 kf[3], vf[3];
            float sa = 0.f, sb = 0.f;
            kf[0] = ATT_KFRAG(0); kf[1] = ATT_KFRAG(1);
#pragma unroll
            for (int i = 0; i < 16; ++i) {
                if (i + 2 < 16) kf[(i + 2) % 3] = ATT_KFRAG(i + 2);
                if ((i & 3) == 2) { if (has_next) { switch (i >> 2) {
                    case 0: dma_piece<0>(kvo, vvo, kbn, vbn, kdn, vdn); break; case 1: dma_piece<1>(kvo, vvo, kbn, vbn, kdn, vdn); break;
                    case 2: dma_piece<2>(kvo, vvo, kbn, vbn, kdn, vdn); break; default: dma_piece<3>(kvo, vvo, kbn, vbn, kdn, vdn); break; } } }
                if (i == 14) ATT_VFRAG(vf[0], 0);
                if (i == 15) ATT_VFRAG(vf[1], 1);
                if (i < 8) {
                    if (i == 0) s0 = __builtin_amdgcn_mfma_f32_32x32x16_bf16(kf[0], qr[0], f32x16{}, 0, 0, 0);
                    else s0 = __builtin_amdgcn_mfma_f32_32x32x16_bf16(kf[i % 3], qr[i], s0, 0, 0, 0);
                } else {
                    const int ks = i - 8;
                    if (ks == 0) s1 = __builtin_amdgcn_mfma_f32_32x32x16_bf16(kf[i % 3], qr[0], f32x16{}, 0, 0, 0);
                    else s1 = __builtin_amdgcn_mfma_f32_32x32x16_bf16(kf[i % 3], qr[ks], s1, 0, 0, 0);
                    s0[2 * ks] = __builtin_amdgcn_exp2f(SHIFT ? s0[2 * ks] - cshift : s0[2 * ks]); s0[2 * ks + 1] = __builtin_amdgcn_exp2f(SHIFT ? s0[2 * ks + 1] - cshift : s0[2 * ks + 1]);
                    if (ks >= 1) { sa += s0[2 * ks - 2] + s0[2 * ks - 1]; pw[(ks - 1) >> 2][(ks - 1) & 3] = cvtpk_s(s0[2 * ks - 2], s0[2 * ks - 1]); }
                }
                ATT_SB();
            }
#pragma unroll
            for (int j = 0; j < 32; ++j) {
                if (j + 2 < 32) ATT_VFRAG(vf[(j + 2) % 3], j + 2);
                if ((j & 3) == 1 && j < 16) { if (has_next) { switch (4 + (j >> 2)) {
                    case 0: dma_piece<0>(kvo, vvo, kbn, vbn, kdn, vdn); break; case 1: dma_piece<1>(kvo, vvo, kbn, vbn, kdn, vdn); break;
                    case 2: dma_piece<2>(kvo, vvo, kbn, vbn, kdn, vdn); break; case 3: dma_piece<3>(kvo, vvo, kbn, vbn, kdn, vdn); break;
                    case 4: dma_piece<4>(kvo, vvo, kbn, vbn, kdn, vdn); break; case 5: dma_piece<5>(kvo, vvo, kbn, vbn, kdn, vdn); break;
                    case 6: dma_piece<6>(kvo, vvo, kbn, vbn, kdn, vdn); break; default: dma_piece<7>(kvo, vvo, kbn, vbn, kdn, vdn); break; } } }
                o[j & 7] = __builtin_amdgcn_mfma_f32_32x32x16_bf16(vf[j % 3], __builtin_bit_cast(bf16x8, pw[j >> 3]), o[j & 7], 0, 0, 0);
                if (j == 0) { sa += s0[14] + s0[15]; pw[1][3] = cvtpk_s(s0[14], s0[15]); }
                if (j < 16) s1[j] = __builtin_amdgcn_exp2f(SHIFT ? s1[j] - cshift : s1[j]);
                if (j >= 1 && j < 17) sb += s1[j - 1];
                if (j >= 2 && j < 18 && !(j & 1)) pw[2 + ((j - 2) >> 3)][((j - 2) & 7) >> 1] = cvtpk_s(s1[j - 2], s1[j - 1]);
                ATT_SB();
            }
            lsum += sa + sb;
#undef ATT_KFRAG
#undef ATT_VFRAG
        }
    }
#undef ATT_SB
    const float l = xor32_sum(lsum);
    const float inv = 1.0f / l;
    ATT_WAIT_BAR();
    LAS f32x4* X = (LAS f32x4*)shm;
    if (comp == 1) {
        const float sc = inv * lam;
#pragma unroll
        for (int d0 = 0; d0 < 8; ++d0)
#pragma unroll
            for (int r4 = 0; r4 < 4; ++r4)
                { X[(w * 32 + d0 * 4 + r4) * 64 + lane] = (f32x4){o[d0][4 * r4] * sc, o[d0][4 * r4 + 1] * sc, o[d0][4 * r4 + 2] * sc, o[d0][4 * r4 + 3] * sc}; __builtin_amdgcn_sched_barrier(0); }
    }
    ATT_WAIT_BAR();
    if (comp == 0) {
        float ss = 0.f;
#pragma unroll
        for (int d0 = 0; d0 < 8; ++d0)
#pragma unroll
            for (int r4 = 0; r4 < 4; ++r4) {
                const f32x4 x = X[(w * 32 + d0 * 4 + r4) * 64 + lane];
#pragma unroll
                for (int i = 0; i < 4; ++i) { const float dd = o[d0][4 * r4 + i] * inv - x[i]; o[d0][4 * r4 + i] = dd; ss += dd * dd; }
                if (r4 == 3) __builtin_amdgcn_sched_barrier(0);
            }
        ss = xor32_sum(ss);
        const float rstd = __builtin_amdgcn_rsqf(ss * (1.0f / 256.0f) + NORM_EPS) * osc;
        bf16_t* orow = O + (size_t)(q0 + 32 * w + r32) * D + h * 256 + 4 * hi;
#pragma unroll
        for (int d0 = 0; d0 < 8; ++d0)
#pragma unroll
            for (int r4 = 0; r4 < 4; ++r4) {
                const int dv = 32 * d0 + 8 * r4;
                const f32x4 g4 = *(const f32x4*)(subg + dv + 4 * hi);
                u32x2 wv; wv.x = cvt_pk_bf16(o[d0][4 * r4] * rstd * g4[0], o[d0][4 * r4 + 1] * rstd * g4[1]); wv.y = cvt_pk_bf16(o[d0][4 * r4 + 2] * rstd * g4[2], o[d0][4 * r4 + 3] * rstd * g4[3]);
                *(u32x2*)(orow + dv) = wv;
                if (r4 == 3) __builtin_amdgcn_sched_barrier(0);
            }
    }
    ATT_WAIT_BAR();
#undef ATT_DMA
}

template <int IDX> __device__ __forceinline__ void dma_piece2(unsigned kvo, unsigned vvo, const char* kbn, const char* vbn, unsigned kdn, unsigned vdn) {
    unsigned keep, tv;
    if constexpr (IDX < 2) {
        constexpr int dl = IDX * 16; const unsigned dst = kdn + IDX * 0x400;
        asm volatile("s_mov_b32 %0, m0\n\ts_mov_b32 m0, %3\n\tv_add_u32 %1, %4, %2\n\ts_nop 0\n\tglobal_load_lds_dwordx4 %1, %5\n\ts_mov_b32 m0, %0"
                     : "=&s"(keep), "=&v"(tv) : "v"(kvo), "s"(dst), "i"(dl), "s"(kbn) : "memory");
    } else {
        constexpr int dl = (IDX - 2) * 0x8000; const unsigned dst = vdn + (IDX - 2) * 0x400;
        asm volatile("s_mov_b32 %0, m0\n\ts_mov_b32 m0, %3\n\tv_add_u32 %1, %4, %2\n\ts_nop 0\n\tglobal_load_lds_dwordx4 %1, %5\n\ts_mov_b32 m0, %0"
                     : "=&s"(keep), "=&v"(tv) : "v"(vvo), "s"(dst), "i"(dl), "s"(vbn) : "memory");
    }
}
template <bool SHIFT, bool LATE> __device__ __forceinline__ void attn_item2(int h, int comp, int qb, const bf16_t* Q, const bf16_t* Kt, const bf16_t* V, bf16_t* O, char* shm, float oscale, float cshift, int wv) {
    constexpr int STG = 49152, VOFF = 16384;
    int tid_ = (wv << 6) | lane_id(); asm volatile("" : "+v"(tid_));
    const int tid = tid_, lane = tid & 63, r32 = lane & 31, hi = lane >> 5;
    const int wid = __builtin_amdgcn_readfirstlane(tid >> 6);
    const int q0 = qb * 256;
    const unsigned lds0 = (unsigned)(uintptr_t)shm;
    const lds_cptr shm3 = (lds_cptr)shm;
    const unsigned kvo = (unsigned)(lane * D + wid * 16) * 2u;
    const unsigned vvo = (unsigned)((lane >> 2) * D + wid * 32 + (lane & 3) * 8) * 2u;
    const char* kbase = (const char*)(Kt + h * 256 + comp * 128);
    const char* vbase = (const char*)(V + h * 256);
    const int NT = 4 * qb + 4, NTw = 4 * qb + 1 + (wv >> 1);
    {
        const unsigned kd0 = (unsigned)__builtin_amdgcn_readfirstlane(lds0 + wid * 2048), vd0 = (unsigned)__builtin_amdgcn_readfirstlane(lds0 + VOFF + wid * 4096);
        dma_piece2<0>(kvo, vvo, kbase, vbase, kd0, vd0); dma_piece2<1>(kvo, vvo, kbase, vbase, kd0, vd0); dma_piece2<2>(kvo, vvo, kbase, vbase, kd0, vd0);
        dma_piece2<3>(kvo, vvo, kbase, vbase, kd0, vd0); dma_piece2<4>(kvo, vvo, kbase, vbase, kd0, vd0); dma_piece2<5>(kvo, vvo, kbase, vbase, kd0, vd0);
    }
    bf16x8 qr[8];
    { const bf16_t* qp = Q + (size_t)(q0 + 32 * wid + r32) * D + h * 256 + comp * 128 + hi * 8;
#pragma unroll
      for (int ks = 0; ks < 8; ++ks) qr[ks] = *(const bf16x8*)(qp + ks * 16); }
    f32x16 o[8];
#pragma unroll
    for (int d0 = 0; d0 < 8; ++d0) o[d0] = f32x16{};
    float lsum = 0.f;
    const int koff = hi * 1024 + r32 * 16;
    const int voff = VOFF + ((r32 >> 4) & 1) * 32 + (r32 & 3) * 8 + (4 * hi + ((r32 & 15) >> 2)) * 64;
#define ATT_SB() __builtin_amdgcn_sched_barrier(0)
#define ATT_KFRAG(i_) (*(const LAS bf16x8*)(kb + ((i_) & 7) * 2048 + ((i_) >> 3) * 512))
#define ATT_VFRAG(dst, vb_, j_) do { const v4i16_t lo_ = vtr((vb_) + ((j_) & 7) * 4096 + ((j_) >> 3) * 1024), hh_ = vtr((vb_) + ((j_) & 7) * 4096 + ((j_) >> 3) * 1024 + 512); \
        dst = (bf16x8){lo_[0], lo_[1], lo_[2], lo_[3], hh_[0], hh_[1], hh_[2], hh_[3]}; } while (0)
#define ATT_P2(ix) dma_piece2<ix>(kvo, vvo, kbn, vbn, kdn, vdn)
#define ATT_QK_PVA(PRE) do { \
            const lds_cptr kb = shm3 + st + koff; const lds_cptr vb = shm3 + st + voff; \
            f32x16 s0, s1; float sa = 0.f, sb = 0.f; bf16x8 kf[3]; \
            kf[0] = ATT_KFRAG(0); kf[1] = ATT_KFRAG(1); \
            _Pragma("unroll") for (int i = 0; i < 16; ++i) { \
                if (i + 2 < 16) kf[(i + 2) % 3] = ATT_KFRAG(i + 2); \
                if (i == 4) { if (has_next) ATT_P2(0); } \
                if (i == 12) { if (has_next) ATT_P2(1); } \
                if (i == 14) ATT_VFRAG(vf[0], vb, 0); \
                if (i == 15) ATT_VFRAG(vf[1], vb, 1); \
                if (i < 8) { \
                    if (i == 0) s0 = __builtin_amdgcn_mfma_f32_32x32x16_bf16(kf[0], qr[0], f32x16{}, 0, 0, 0); \
                    else s0 = __builtin_amdgcn_mfma_f32_32x32x16_bf16(kf[i % 3], qr[i], s0, 0, 0, 0); \
                } else { \
                    const int ks = i - 8; \
                    if (ks == 0) s1 = __builtin_amdgcn_mfma_f32_32x32x16_bf16(kf[i % 3], qr[0], f32x16{}, 0, 0, 0); \
                    else s1 = __builtin_amdgcn_mfma_f32_32x32x16_bf16(kf[i % 3], qr[ks], s1, 0, 0, 0); \
                    s0[2 * ks] = __builtin_amdgcn_exp2f(SHIFT ? s0[2 * ks] - cshift : s0[2 * ks]); s0[2 * ks + 1] = __builtin_amdgcn_exp2f(SHIFT ? s0[2 * ks + 1] - cshift : s0[2 * ks + 1]); \
                    if (ks >= 1) { sa += s0[2 * ks - 2] + s0[2 * ks - 1]; pw[(ks - 1) >> 2][(ks - 1) & 3] = cvtpk_s(s0[2 * ks - 2], s0[2 * ks - 1]); } \
                } \
                ATT_SB(); \
            } \
            _Pragma("unroll") for (int j = 0; j < 16; ++j) { \
                if (j + 2 < 16 || (PRE)) ATT_VFRAG(vf[(j + 2) % 3], vb, j + 2); \
                if (j == 1) { if (has_next) ATT_P2(2); } \
                if (j == 5) { if (has_next) ATT_P2(3); } \
                if (j == 9) { if (has_next) ATT_P2(4); } \
                if (j == 13) { if (has_next) ATT_P2(5); } \
                o[j & 7] = __builtin_amdgcn_mfma_f32_32x32x16_bf16(vf[j % 3], __builtin_bit_cast(bf16x8, pw[j >> 3]), o[j & 7], 0, 0, 0); \
                if (j == 0) { sa += s0[14] + s0[15]; pw[1][3] = cvtpk_s(s0[14], s0[15]); } \
                s1[j] = __builtin_amdgcn_exp2f(SHIFT ? s1[j] - cshift : s1[j]); \
                if (j >= 1) sb += s1[j - 1]; \
                if (j >= 2 && !(j & 1)) pw[2 + ((j - 2) >> 3)][((j - 2) & 7) >> 1] = cvtpk_s(s1[j - 2], s1[j - 1]); \
                ATT_SB(); \
            } \
            sb += s1[15]; pw[3][3] = cvtpk_s(s1[14], s1[15]); \
            lsum += sa + sb; \
            ATT_SB(); \
        } while (0)
#define ATT_PVB(vb_, PRO) do { \
            if (PRO) { ATT_VFRAG(vf[16 % 3], (vb_), 16); ATT_VFRAG(vf[17 % 3], (vb_), 17); } \
            __builtin_amdgcn_s_setprio(1);        \
            _Pragma("unroll") for (int j = 16; j < 32; ++j) { \
                if (j + 2 < 32) ATT_VFRAG(vf[(j + 2) % 3], (vb_), j + 2); \
                o[j & 7] = __builtin_amdgcn_mfma_f32_32x32x16_bf16(vf[j % 3], __builtin_bit_cast(bf16x8, pw[j >> 3]), o[j & 7], 0, 0, 0); \
                ATT_SB(); \
            } \
            __builtin_amdgcn_s_setprio(0); \
        } while (0)
    u32x4 pw[4];
    bf16x8 vf[3];
    constexpr bool late = LATE;
    int st = 0, stp = 2 * STG, stn = STG;
    for (int t = 0; t < NT; ++t) {
        ATT_WAIT_BAR();
        const bool has_next = (t + 1 < NT);
        const char* kbn = kbase + (size_t)(t + 1) * (KV * D * 2); const char* vbn = vbase + (size_t)(t + 1) * (KV * D * 2);
        const unsigned kdn = (unsigned)__builtin_amdgcn_readfirstlane(lds0 + stn + wid * 2048), vdn = (unsigned)__builtin_amdgcn_readfirstlane(lds0 + stn + VOFF + wid * 4096);
        if (late) { if (t >= 1 && t - 1 < NTw) ATT_PVB(shm3 + stp + voff, true); }
        if (t < NTw) ATT_QK_PVA(false);
        else if (has_next) { ATT_P2(0); ATT_P2(1); ATT_P2(2); ATT_P2(3); ATT_P2(4); ATT_P2(5); }
        if (!late) { if (t < NTw) ATT_PVB(shm3 + st + voff, true); }
        stp = st; st = stn; stn = (stn == 2 * STG) ? 0 : stn + STG;
    }
    if (late) { if (NT - 1 < NTw) ATT_PVB(shm3 + stp + voff, true); }
#undef ATT_SB
#undef ATT_KFRAG
#undef ATT_VFRAG
#undef ATT_P2
#undef ATT_QK_PVA
#undef ATT_PVB
    const float sc = oscale / xor32_sum(lsum);
    ATT_WAIT_BAR();
    LAS unsigned char* stg = (LAS unsigned char*)shm + wid * 16896;
#pragma unroll
    for (int d0 = 0; d0 < 8; ++d0)
#pragma unroll
        for (int r4 = 0; r4 < 4; ++r4) {
            const int dv = 32 * d0 + 8 * r4 + 4 * hi;
            u32x2 wv2; wv2.x = cvt_pk_bf16(o[d0][4 * r4] * sc, o[d0][4 * r4 + 1] * sc); wv2.y = cvt_pk_bf16(o[d0][4 * r4 + 2] * sc, o[d0][4 * r4 + 3] * sc);
            *(LAS u32x2*)(stg + r32 * 528 + dv * 2) = wv2;
            if (r4 == 3) __builtin_amdgcn_sched_barrier(0);
        }
    asm volatile("s_waitcnt lgkmcnt(0)" ::: "memory");
    bf16_t* obase = O + (size_t)(q0 + 32 * wid) * D + h * 256 + (lane & 31) * 8;
#pragma unroll
    for (int i = 0; i < 16; ++i) {
        const int row = 2 * i + (lane >> 5);
        const u32x4 v = *(const LAS u32x4*)(stg + row * 528 + (lane & 31) * 16);
        *(u32x4*)(obase + (size_t)row * D) = v;
    }
    ATT_WAIT_BAR();
}
}

struct Args { const float* in[16]; float* out; unsigned char* ws; float invf[16]; };

__device__ __forceinline__ float wave_sum(float v) {
#pragma unroll
    for (int o = 1; o < 64; o <<= 1) v += __shfl_xor(v, o);
    return v;
}
__device__ __forceinline__ float wave_max(float v) {
#pragma unroll
    for (int o = 1; o < 64; o <<= 1) v = fmaxf(v, __shfl_xor(v, o));
    return v;
}
__device__ __forceinline__ unsigned f2bf(float f) { unsigned u = __builtin_bit_cast(unsigned, f); return (u + 0x7fffu + ((u >> 16) & 1u)) >> 16; }
__device__ __forceinline__ unsigned pk2(float lo, float hi) { return f2bf(lo) | (f2bf(hi) << 16); }

__device__ __forceinline__ void p0_transpose_item(const float* W, int K, int N, bf16_t* WT, int dest_row0, const float* gk, LAS float* scr, int k0, int n0, int lane) {
    float wv_[32];
    const float* wp = W + (size_t)(k0 + (lane >> 5)) * N + n0 + (lane & 31);
#pragma unroll
    for (int i = 0; i < 32; ++i) wv_[i] = wp[(size_t)(2 * i) * N];
    if (gk) {
#pragma unroll
        for (int i = 0; i < 32; ++i) wv_[i] *= gk[k0 + 2 * i + (lane >> 5)];
    }
#pragma unroll
    for (int i = 0; i < 32; ++i) scr[(2 * i + (lane >> 5)) * 33 + (lane & 31)] = wv_[i];
    asm volatile("s_waitcnt lgkmcnt(0)" ::: "memory");
    const int c = lane & 7;
#pragma unroll
    for (int j = 0; j < 4; ++j) { const int n = (lane >> 3) + 8 * j; const LAS float* s = scr + (8 * c) * 33 + n;
        u32x4 o; o.x = cvt_pk_bf16(s[0 * 33], s[1 * 33]); o.y = cvt_pk_bf16(s[2 * 33], s[3 * 33]); o.z = cvt_pk_bf16(s[4 * 33], s[5 * 33]); o.w = cvt_pk_bf16(s[6 * 33], s[7 * 33]);
        *(u32x4*)(WT + (size_t)(dest_row0 + n) * K + k0 + 8 * c) = o; }
    asm volatile("s_waitcnt lgkmcnt(0)" ::: "memory");
}

__device__ __forceinline__ void sincos_d(float angf, float& sn, float& cs) {
    const double a = (double)angf;
    const double n = rint(a * 0.63661977236758134308);
    double r = fma(-n, 1.57079632679489655800, a); r = fma(-n, 6.12323399573676603587e-17, r);
    const int q = ((int)n) & 3;
    const double r2 = r * r;
    const double sp = r * (1.0 + r2 * (-1.0 / 6 + r2 * (1.0 / 120 + r2 * (-1.0 / 5040 + r2 * (1.0 / 362880 + r2 * (-1.0 / 39916800 + r2 * (1.0 / 6227020800.0)))))));
    const double cp = 1.0 + r2 * (-0.5 + r2 * (1.0 / 24 + r2 * (-1.0 / 720 + r2 * (1.0 / 40320 + r2 * (-1.0 / 3628800 + r2 * (1.0 / 479001600.0 + r2 * (-1.0 / 87178291200.0)))))));
    const double s_ = (q == 0) ? sp : (q == 1) ? cp : (q == 2) ? -sp : -cp;
    const double c_ = (q == 0) ? cp : (q == 1) ? -sp : (q == 2) ? -cp : sp;
    sn = (float)s_; cs = (float)c_;
}

__device__ __forceinline__ void pooled_tile(const bf16_t* up, bf16_t* pooled, int pm, int g, int tid) {
    asm volatile("" : "+v"(tid));
    const int col = 256 * g + 8 * (tid & 31), wdw = 2 << g, t0 = 256 * pm + 16 * (tid >> 5);
    f32x4 sA = {0.f, 0.f, 0.f, 0.f}, sB = {0.f, 0.f, 0.f, 0.f};
    for (int i = 1; i <= wdw; ++i) { const int t = t0 - i; if (t >= 0) { f32x4 a, b; unpack8(*(const u32x4*)(up + (size_t)t * D + col), a, b); sA += a; sB += b; } }
#pragma unroll 4
    for (int tt = 0; tt < 16; ++tt) {
        const int t = t0 + tt;
        f32x4 ca, cb; unpack8(*(const u32x4*)(up + (size_t)t * D + col), ca, cb);
        sA += ca; sB += cb;
        if (t - wdw >= 0) { f32x4 a, b; unpack8(*(const u32x4*)(up + (size_t)(t - wdw) * D + col), a, b); sA -= a; sB -= b; }
        const float rc = 1.0f / (float)((t + 1 < wdw) ? (t + 1) : wdw);
        *(u32x4*)(pooled + (size_t)t * D + col) = pack8(sA * rc - ca, sB * rc - cb);
    }
}

__device__ __forceinline__ void fill_rstd(LAS float* xl, const float* ssq, const pg8::StaticOrder& S, int tid) {
    if (tid < 256) {
#pragma unroll
        for (int i = 0; i < 6; ++i) { pg8::Unit u; if (S.next(i, u)) { const int r = u.pm * 256 + tid;
            xl[XL_BYTES / 4 + i * 256 + tid] = __builtin_amdgcn_rsqf(((ssq[r] + ssq[M + r]) + (ssq[2 * M + r] + ssq[3 * M + r])) * (1.0f / 1024.0f) + NORM_EPS); } }
    }
    __syncthreads();
}
typedef const __attribute__((address_space(4))) Args* KArgsPtr;
#define KARGS(ap) KArgsPtr ap = (KArgsPtr)__builtin_amdgcn_kernarg_segment_ptr(); asm volatile("" : "+s"(ap))

__global__ void __launch_bounds__(NTHREADS, 2) fwd_megakernel(Args args_unused) {
    extern __shared__ __attribute__((aligned(16))) unsigned char lds_raw[];
    cg::grid_group grid = cg::this_grid();
    LAS unsigned char* lds = (LAS unsigned char*)lds_raw;
    LAS float* xl = (LAS float*)(lds + XL_OFF);
    const int wv = __builtin_amdgcn_readfirstlane(threadIdx.x >> 6);
    volatile LAS unsigned* bst = (volatile LAS unsigned*)(lds + LDS_BYTES - 16);
    if (wv == 0) { if (lane_id() == 0) { bst[0] = 0u; bst[1] = 0u; KARGS(ap0); (void)xb_add((unsigned*)(ap0->ws + WS_BAR) + XB_XCNT(xb_xcc_id()), 1u); } }
    __syncthreads();
#define GRID_BAR() do { KARGS(apb); grid_barrier((unsigned*)(apb->ws + WS_BAR), bst, wv); } while (0)
    if (gridDim.x == 0x7fffffffu) grid.sync();

    {
        KARGS(ap);
        unsigned char* ws = ap->ws;
        const int bx = blockIdx.x, G = gridDim.x, vcu = (bx % 8) * (G / 8) + bx / 8;
        int tid = (wv << 6) | lane_id(); asm volatile("" : "+v"(tid));
        const int lane = tid & 63, wave = wv;
        LAS float* scr = (LAS float*)(lds + wave * 16384);
        const int gw = vcu * NWAVES + wave, NGW = G * NWAVES;
        constexpr int I_IN = 16 * 192, I_OUT = 16 * 32, I_FF = 16 * 176, I_FO = 44 * 32, I_PL = 128, I_LAYER = I_IN + I_OUT + I_FF + I_FO + I_PL;
        for (int it = gw; it < DEPTH * I_LAYER; it += NGW) {
            const int L = it / I_LAYER; int r = it % I_LAYER;
            unsigned char* wl = ws + WS_W + (size_t)L * LAYER_W;
            if (r < I_IN) { const int kb = r / 192, nb = r % 192;
                p0_transpose_item(ap->in[2] + (size_t)L * D * NIN, D, NIN, (bf16_t*)(wl + OFF_WIN), 32 * nb, ap->in[1] + L * D, scr, 64 * kb, 32 * nb, lane); continue; }
            r -= I_IN;
            if (r < I_OUT) { const int kb = r / 32, nb = r % 32;
                p0_transpose_item(ap->in[12] + (size_t)L * D * D, D, D, (bf16_t*)(wl + OFF_WOUT), 32 * nb, nullptr, scr, 64 * kb, 32 * nb, lane); continue; }
            r -= I_OUT;
            if (r < I_FF) { const int kb = r / 176, nb = r % 176; const int n0 = 32 * nb, up = (n0 >= FF) ? 1 : 0, j = n0 - up * FF;
                p0_transpose_item(ap->in[14] + (size_t)L * D * NFF2, D, NFF2, (bf16_t*)(wl + OFF_WFF), 256 * (j / 128) + 128 * up + (j % 128), ap->in[13] + L * D, scr, 64 * kb, n0, lane); continue; }
            r -= I_FF;
            if (r < I_FO) { const int kb = r / 32, nb = r % 32;
                p0_transpose_item(ap->in[15] + (size_t)L * FF * D, FF, D, (bf16_t*)(wl + OFF_WFO), 32 * nb, nullptr, scr, 64 * kb, 32 * nb, lane); continue; }
            r -= I_FO;
            { const int gg = r / 32, rr = r % 32, kb = rr / 8, nb = rr % 8;
                p0_transpose_item(ap->in[10] + (size_t)L * 4 * 65536 + (size_t)gg * 65536, 256, 256, (bf16_t*)(wl + OFF_POOL) + (size_t)gg * 65536, 32 * nb, nullptr, scr, 64 * kb, 32 * nb, lane); }
        }
        const float* x_in = ap->in[0];
        bf16_t* xb = (bf16_t*)(ws + WS_XB); float* ssq = (float*)(ws + WS_SSQ);
        for (int m = gw; m < M; m += NGW) {
            const f32x4* xr = (const f32x4*)(x_in + (size_t)m * D) + lane;
            float s = 0.f;
#pragma unroll
            for (int j = 0; j < 4; ++j) { const f32x4 v = xr[64 * j]; s += (v[0] * v[0] + v[1] * v[1]) + (v[2] * v[2] + v[3] * v[3]);
                u32x2 w2; w2.x = cvt_pk_bf16(v[0], v[1]); w2.y = cvt_pk_bf16(v[2], v[3]); *((u32x2*)(xb + (size_t)m * D) + lane + 64 * j) = w2; }
            s = wave_sum(s);
            if (lane < 4) ssq[(size_t)lane * M + m] = (lane == 0) ? s : 0.f;
        }
        float* rcos = (float*)(ws + WS_COS); float* rsin = (float*)(ws + WS_SIN);
        for (int idx = vcu * NTHREADS + tid; idx < M * 16; idx += G * NTHREADS) {
            const int pos = idx >> 4, j = idx & 15;
            const float ang = (float)pos * ap->invf[j];
            float sn, cs; sincos_d(ang, sn, cs);
            rcos[idx] = cs; rsin[idx] = sn;
        }
    }
    GRID_BAR();

#pragma unroll 1
    for (int L = 0; L < DEPTH; ++L) {
        {
            KARGS(ap); unsigned char* ws = ap->ws; unsigned char* wl = ws + WS_W + (size_t)L * LAYER_W;
            pg8::Gemm g{(const bf16_t*)(ws + WS_XB), (const bf16_t*)(wl + OFF_WIN), D, D, D, 0};
            int bxl = blockIdx.x; asm volatile("" : "+s"(bxl)); pg8::StaticOrder S; S.init(M, NIN, GRID, bxl);
            pg8::EpiIn E{ws, ap->in[3] + L * 128, ap->in[4] + L * 128, xl};
            fill_rstd(xl, (const float*)(ws + WS_SSQ), S, (wv << 6) | lane_id());
            pg8::gemm_phase<pg8::EpiIn, true>(lds, g, S, E, wv);
        }
        GRID_BAR();
        {
            KARGS(ap); unsigned char* ws = ap->ws;
            int ln = lane_id(); asm volatile("" : "+v"(ln));
            const float lam_init = 0.8f - 0.6f * expf(-0.3f * (float)L);
            const float* lq1 = ap->in[5] + L * 128; const float* lk1 = ap->in[6] + L * 128; const float* lq2 = ap->in[7] + L * 128; const float* lk2 = ap->in[8] + L * 128;
            const float d1 = wave_sum_rl(lq1[ln] * lk1[ln] + lq1[ln + 64] * lk1[ln + 64]);
            const float d2 = wave_sum_rl(lq2[ln] * lk2[ln] + lq2[ln + 64] * lk2[ln + 64]);
            const float lam = expf(d1) - expf(d2) + lam_init;
            const float* gq = ap->in[3] + L * 128; const float* gk = ap->in[4] + L * 128;
            const float mq = wave_max_rl(fmaxf(fabsf(gq[ln]), fabsf(gq[ln + 64]))), mk = wave_max_rl(fmaxf(fabsf(gk[ln]), fabsf(gk[ln + 64])));
            const float cshift = 11.313708498984761f * 1.4426950408889634f * mq * mk;
            int bx = blockIdx.x; asm volatile("" : "+s"(bx)); const int vcu = (bx % 8) * (GRID / 8) + bx / 8;
            const int hc = vcu >> 5, p = vcu & 31, h = hc >> 1, comp = hc & 1;
            const bf16_t* act0 = (const bf16_t*)(ws + WS_ACT);
            const bf16_t* Qb = act0 + ACT_ELEMS; const bf16_t* Kb = act0 + 2 * ACT_ELEMS; const bf16_t* Vb = act0 + 3 * ACT_ELEMS;
            bf16_t* Oc = (bf16_t*)(ws + (comp ? WS_XB : WS_ATTN));
            const float oscale = comp ? lam : 1.0f;
            if (cshift <= 64.0f) {
                if (wv >= 4) { att::attn_item2<false, true>(h, comp, 63 - p, Qb, Kb, Vb, Oc, (char*)lds_raw, oscale, 0.0f, wv); att::attn_item2<false, true>(h, comp, p, Qb, Kb, Vb, Oc, (char*)lds_raw, oscale, 0.0f, wv); }
                else         { att::attn_item2<false, false>(h, comp, 63 - p, Qb, Kb, Vb, Oc, (char*)lds_raw, oscale, 0.0f, wv); att::attn_item2<false, false>(h, comp, p, Qb, Kb, Vb, Oc, (char*)lds_raw, oscale, 0.0f, wv); }
            } else {
                if (wv >= 4) { att::attn_item2<true, true>(h, comp, 63 - p, Qb, Kb, Vb, Oc, (char*)lds_raw, oscale, cshift, wv); att::attn_item2<true, true>(h, comp, p, Qb, Kb, Vb, Oc, (char*)lds_raw, oscale, cshift, wv); }
                else         { att::attn_item2<true, false>(h, comp, 63 - p, Qb, Kb, Vb, Oc, (char*)lds_raw, oscale, cshift, wv); att::attn_item2<true, false>(h, comp, p, Qb, Kb, Vb, Oc, (char*)lds_raw, oscale, cshift, wv); }
            }
        }
        GRID_BAR();
        {
            KARGS(ap); unsigned char* ws = ap->ws; unsigned char* wl = ws + WS_W + (size_t)L * LAYER_W;
            bf16_t* act0 = (bf16_t*)(ws + WS_ACT);
            int bxl = blockIdx.x; asm volatile("" : "+s"(bxl)); pg8::StaticOrder S; S.init(M, D, GRID, bxl);
            pg8::Unit u;
            (void)S.next(0, u); pooled_tile(act0, (bf16_t*)(ws + WS_POOLED), u.pm, u.pn, (wv << 6) | lane_id());
            asm volatile("s_waitcnt vmcnt(0)" ::: "memory");
            __syncthreads();
            pg8::Gemm g{(const bf16_t*)(ws + WS_POOLED), (const bf16_t*)(wl + OFF_POOL), D, 256, 256, 256};
            pg8::EpiMerge E{act0 + 4 * ACT_ELEMS, act0 + 5 * ACT_ELEMS, (const bf16_t*)(ws + WS_ATTN), (const bf16_t*)(ws + WS_XB), ap->in[11] + L * D, ap->in[9] + L * 256, (bf16_t*)(ws + WS_MERGED),
                            1.0f - (0.8f - 0.6f * expf(-0.3f * (float)L)), xl};
            pg8::gemm_phase<pg8::EpiMerge, false>(lds, g, S, E, wv);
        }
        GRID_BAR();
        {
            KARGS(ap); unsigned char* ws = ap->ws; unsigned char* wl = ws + WS_W + (size_t)L * LAYER_W;
            pg8::Gemm g{(const bf16_t*)(ws + WS_MERGED), (const bf16_t*)(wl + OFF_WOUT), D, D, D, 0};
            int bxl = blockIdx.x; asm volatile("" : "+s"(bxl)); pg8::StaticOrder S; S.init(M, D, GRID, bxl);
            pg8::EpiRes E{(L == 0) ? ap->in[0] : (const float*)ap->out, ap->out, (bf16_t*)(ws + WS_XB), (float*)(ws + WS_SSQ), lds};
            pg8::gemm_phase<pg8::EpiRes, false>(lds, g, S, E, wv);
        }
        GRID_BAR();
        {
            KARGS(ap); unsigned char* ws = ap->ws; unsigned char* wl = ws + WS_W + (size_t)L * LAYER_W;
            pg8::Gemm g{(const bf16_t*)(ws + WS_XB), (const bf16_t*)(wl + OFF_WFF), D, D, D, 0};
            int bxl = blockIdx.x; asm volatile("" : "+s"(bxl)); pg8::StaticOrder S; S.init(M, NFF2, GRID, bxl);
            pg8::EpiSwiGLU E{(bf16_t*)(ws + WS_FFACT), xl};
            fill_rstd(xl, (const float*)(ws + WS_SSQ), S, (wv << 6) | lane_id());
            pg8::gemm_phase<pg8::EpiSwiGLU, true>(lds, g, S, E, wv);
        }
        GRID_BAR();
        {
            KARGS(ap); unsigned char* ws = ap->ws; unsigned char* wl = ws + WS_W + (size_t)L * LAYER_W;
            pg8::Gemm g{(const bf16_t*)(ws + WS_FFACT), (const bf16_t*)(wl + OFF_WFO), FF, FF, FF, 0};
            int bxl = blockIdx.x; asm volatile("" : "+s"(bxl)); pg8::StaticOrder S; S.init(M, D, GRID, bxl);
            pg8::EpiRes E{(const float*)ap->out, ap->out, (bf16_t*)(ws + WS_XB), (float*)(ws + WS_SSQ), lds};
            pg8::gemm_phase<pg8::EpiRes, false>(lds, g, S, E, wv);
        }
        if (L + 1 < DEPTH) GRID_BAR();
    }
}

extern "C" void kernel_launch(void* const* d_in, const int* in_sizes, int n_in, void* d_out, int out_size, void* d_ws, size_t ws_size, hipStream_t stream) {
    static int ready = 0;
    if (ready == 0) {
        if (n_in != 16 || in_sizes[0] != M * D || out_size != M * D || ws_size < WS_END) {
            fprintf(stderr, "kernel_launch: unexpected shapes (n_in %d, in0 %d, out %d, ws %zu < %zu); nothing launched\n", n_in, n_in > 0 ? in_sizes[0] : -1, out_size, ws_size, (size_t)WS_END); ready = -1; return; }
        if (hipFuncSetAttribute((const void*)fwd_megakernel, hipFuncAttributeMaxDynamicSharedMemorySize, LDS_BYTES) != hipSuccess) { fprintf(stderr, "kernel_launch: hipFuncSetAttribute failed\n"); ready = -1; return; }
        int dev = 0, cus = 0, per_cu = 0;
        (void)hipGetDevice(&dev); (void)hipDeviceGetAttribute(&cus, hipDeviceAttributeMultiprocessorCount, dev);
        (void)hipOccupancyMaxActiveBlocksPerMultiprocessor(&per_cu, (const void*)fwd_megakernel, NTHREADS, LDS_BYTES);
        if (cus * per_cu < GRID) fprintf(stderr, "kernel_launch: note: %d CUs x %d blocks/CU < grid %d\n", cus, per_cu, GRID);
        (void)hipGetLastError();
        ready = 1;
    }
    if (ready < 0) return;
    if (hipMemsetAsync((char*)d_ws + WS_BAR, 0, WS_BAR_BYTES, stream) != hipSuccess) { fprintf(stderr, "kernel_launch: hipMemsetAsync failed\n"); return; }
    Args a{};
    for (int i = 0; i < 16; ++i) a.in[i] = (const float*)d_in[i];
    a.out = (float*)d_out; a.ws = (unsigned char*)d_ws;
    for (int j = 0; j < 16; ++j) a.invf[j] = (float)pow(500000.0, -(double)j / 16.0);
    void* kargs[] = {&a};
    hipError_t e = hipLaunchCooperativeKernel((const void*)fwd_megakernel, dim3(GRID), dim3(NTHREADS), kargs, LDS_BYTES, stream);
    if (e != hipSuccess) fprintf(stderr, "kernel_launch: cooperative launch failed: %s\n", hipGetErrorString(e));
}
```

```cpp
#include <hip/hip_runtime.h>
#include <hip/hip_cooperative_groups.h>
#include <cstdio>
#include <cstdint>
#include <cmath>
namespace cg = cooperative_groups;

#define LAS __attribute__((address_space(3)))
typedef unsigned short bf16_t;
typedef short bf16x8 __attribute__((ext_vector_type(8)));
typedef float f32x4 __attribute__((ext_vector_type(4)));
typedef float f32x16 __attribute__((ext_vector_type(16)));
typedef unsigned u32x4 __attribute__((ext_vector_type(4)));
typedef unsigned u32x2 __attribute__((ext_vector_type(2)));

constexpr int M = 16384, D = 1024, NIN = 6144, FF = 2816, NFF2 = 5632, DEPTH = 4;
constexpr float NORM_EPS = 1e-6f;
constexpr float QSC = 0.08838834764831845f * 1.4426950408889634f;
constexpr size_t ACT_ELEMS = (size_t)M * D;

constexpr size_t MiB = 1u << 20;
constexpr size_t SZ_WIN = (size_t)NIN * D * 2, SZ_WOUT = (size_t)D * D * 2, SZ_WFF = (size_t)NFF2 * D * 2, SZ_WFO = (size_t)D * FF * 2, SZ_POOL = 4 * 256 * 256 * 2;
constexpr size_t OFF_WIN = 0, OFF_WOUT = OFF_WIN + SZ_WIN, OFF_WFF = OFF_WOUT + SZ_WOUT, OFF_WFO = OFF_WFF + SZ_WFF, OFF_POOL = OFF_WFO + SZ_WFO, LAYER_W = OFF_POOL + SZ_POOL;
static_assert(LAYER_W == 31 * MiB, "weights per layer");
constexpr size_t WS_W = 0;
constexpr size_t WS_ACT = 124 * MiB;
constexpr size_t WS_ATTN = WS_ACT + 6 * 32 * MiB;
constexpr size_t WS_XB = WS_ATTN + 32 * MiB;
constexpr size_t WS_SSQ = WS_XB + 32 * MiB;
constexpr size_t WS_COS = WS_SSQ + 4 * M * 4;
constexpr size_t WS_SIN = WS_COS + (size_t)M * 16 * 4;
constexpr size_t WS_BAR = WS_SIN + (size_t)M * 16 * 4;
constexpr size_t WS_BAR_BYTES = 16384;
constexpr size_t WS_END = WS_BAR + WS_BAR_BYTES;
constexpr size_t WS_FFACT = WS_ACT;
constexpr size_t WS_MERGED = WS_ACT + 32 * MiB;
constexpr size_t WS_POOLED = WS_ACT + 64 * MiB;
static_assert((size_t)M * FF * 2 <= 96 * MiB, "ffn activation overlay");

constexpr int RING_BYTES = 131072, XL_OFF = RING_BYTES, XL_BYTES = 8192, LDS_BYTES = 163840;
constexpr int NWAVES = 8, NTHREADS = 512, GRID = 256;

__device__ __forceinline__ unsigned cvt_pk_bf16(float lo, float hi) { unsigned r; asm volatile("v_cvt_pk_bf16_f32 %0, %1, %2" : "=v"(r) : "v"(lo), "v"(hi)); return r; }
__device__ __forceinline__ float bf_lo(unsigned w) { return __uint_as_float(w << 16); }
__device__ __forceinline__ float bf_hi(unsigned w) { return __uint_as_float(w & 0xffff0000u); }
__device__ __forceinline__ u32x4 pack8(const f32x4 a, const f32x4 b) { u32x4 w; w.x = cvt_pk_bf16(a[0], a[1]); w.y = cvt_pk_bf16(a[2], a[3]); w.z = cvt_pk_bf16(b[0], b[1]); w.w = cvt_pk_bf16(b[2], b[3]); return w; }
__device__ __forceinline__ void unpack8(const u32x4 w, f32x4& a, f32x4& b) { a = (f32x4){bf_lo(w.x), bf_hi(w.x), bf_lo(w.y), bf_hi(w.y)}; b = (f32x4){bf_lo(w.z), bf_hi(w.z), bf_lo(w.w), bf_hi(w.w)}; }
__device__ __forceinline__ float sigmoidf_(float x) { return __builtin_amdgcn_rcpf(1.0f + __builtin_amdgcn_exp2f(-1.4426950408889634f * x)); }
__device__ __forceinline__ int lane_id() { int r; asm volatile("v_mbcnt_lo_u32_b32 %0, -1, 0\n\tv_mbcnt_hi_u32_b32 %0, -1, %0" : "=v"(r)); return r; }
#define XB_TMO      128
#define XB_XCNT(j)  (256  + 64 * (j))
#define XB_XSUB(j)  (1280 + 64 * (j))
#define XB_XGEN(j)  (2304 + 64 * (j))
#define XB_TOP      3328
#define XB_TOPGEN   3392
#define XCD_BAR_WORDS 3456
#define XB_SPIN_CAP (1u << 22)
__device__ __forceinline__ unsigned xb_ld(unsigned* p)              { return __hip_atomic_load(p, __ATOMIC_RELAXED, __HIP_MEMORY_SCOPE_AGENT); }
__device__ __forceinline__ unsigned xb_add(unsigned* p, unsigned v) { return __hip_atomic_fetch_add(p, v, __ATOMIC_RELAXED, __HIP_MEMORY_SCOPE_AGENT); }
__device__ __forceinline__ unsigned xb_xcc_id() { return (unsigned)__builtin_amdgcn_s_getreg((3 << 11) | 20) & 0xFu; }
#define XB_SPIN(cond, bar) do { unsigned _sp = 0; while (cond) { __builtin_amdgcn_s_sleep(1); \
    if ((++_sp & 255u) == 0u) { if (xb_ld(&(bar)[XB_TMO])) break; if (_sp > XB_SPIN_CAP) { atomicAdd(&(bar)[XB_TMO], 1u); break; } } } } while (0)
__device__ __forceinline__ void xcd_barrier_complete(unsigned* bar, unsigned x, unsigned& nloc, unsigned& nx) {
    const unsigned G = gridDim.x;
    unsigned sum, cnt, mine, sp = 0u;
    for (;;) {
        sum = 0u; cnt = 0u; mine = 0u;
#pragma unroll
        for (unsigned j = 0; j < 16; ++j) { const unsigned c = xb_ld(&bar[XB_XCNT(j)]); sum += c; cnt += (c > 0u) ? 1u : 0u; mine = (j == x) ? c : mine; }
        if (sum == G) break;
        __builtin_amdgcn_s_sleep(1);
        if ((++sp & 255u) == 0u) { if (xb_ld(&bar[XB_TMO])) break; if (sp > XB_SPIN_CAP) { atomicAdd(&bar[XB_TMO], 1u); break; } }
    }
    nloc = mine > 0u ? mine : 1u; nx = cnt > 0u ? cnt : 1u;
}
__device__ __forceinline__ void grid_barrier(unsigned* bar, volatile LAS unsigned* st, int wv) {
    asm volatile("s_waitcnt vmcnt(0) lgkmcnt(0)" ::: "memory");
    __syncthreads();
    if (wv == 0) {
        if (lane_id() == 0) {
            const unsigned x = xb_xcc_id();
            unsigned nloc = st[0], nx = st[1];
            if (nloc == 0u) { xcd_barrier_complete(bar, x, nloc, nx); st[0] = nloc; st[1] = nx; }
            const unsigned old = xb_add(&bar[XB_XSUB(x)], 1u);
            const unsigned gen = old / nloc;
            if (old + 1u == (gen + 1u) * nloc) {
                __builtin_amdgcn_fence(__ATOMIC_RELEASE, "agent");
                asm volatile("s_waitcnt vmcnt(0)" ::: "memory");
                const unsigned og = xb_add(&bar[XB_TOP], 1u);
                const unsigned tg = og / nx;
                if (og + 1u == (tg + 1u) * nx) xb_add(&bar[XB_TOPGEN], 1u);
                else XB_SPIN(xb_ld(&bar[XB_TOPGEN]) == tg, bar);
                __builtin_amdgcn_fence(__ATOMIC_ACQUIRE, "agent");
                xb_add(&bar[XB_XGEN(x)], 1u);
                asm volatile("s_waitcnt vmcnt(0)" ::: "memory");
            } else {
                XB_SPIN(xb_ld(&bar[XB_XGEN(x)]) == gen, bar);
                __builtin_amdgcn_fence(__ATOMIC_ACQUIRE, "agent");
                asm volatile("s_waitcnt vmcnt(0)" ::: "memory");
            }
        }
    }
    __syncthreads();
}
__device__ __forceinline__ float xor32_sum(float v) { auto rr = __builtin_amdgcn_permlane32_swap(__float_as_uint(v), __float_as_uint(v), false, false); return __uint_as_float(rr[0]) + __uint_as_float(rr[1]); }
__device__ __forceinline__ float xor32_get(float v, int hi) { auto rr = __builtin_amdgcn_permlane32_swap(__float_as_uint(v), __float_as_uint(v), false, false); return hi ? __uint_as_float(rr[0]) : __uint_as_float(rr[1]); }
__device__ __forceinline__ float xor16_sum(float v) { return v + __uint_as_float((unsigned)__builtin_amdgcn_ds_swizzle((int)__float_as_uint(v), 0x401F)); }
__device__ __forceinline__ float wave_sum_rl(float v) { float s = 0.f;
#pragma unroll
    for (int i = 0; i < 64; ++i) s += __uint_as_float((unsigned)__builtin_amdgcn_readlane((int)__float_as_uint(v), i));
    return s; }
__device__ __forceinline__ float wave_max_rl(float v) { float s = 0.f;
#pragma unroll
    for (int i = 0; i < 64; ++i) s = fmaxf(s, __uint_as_float((unsigned)__builtin_amdgcn_readlane((int)__float_as_uint(v), i)));
    return s; }
#define LDS_BAR() do { asm volatile("s_waitcnt lgkmcnt(0)" ::: "memory"); __builtin_amdgcn_s_barrier(); asm volatile("" ::: "memory"); } while (0)

namespace pg8 {
constexpr int BM = 256, BK = 64, HALF = 128, HTB = HALF * BK * 2, NXCD = 8, WGM = 8;
__device__ __forceinline__ int lds_byte(int r, int c) { const int st = (r >> 4) * 2 + (c >> 5), rr = r & 15, cc = c & 31, ob = rr * 64 + cc * 2; return st * 1024 + (ob ^ (((ob >> 9) & 1) << 5)); }
__device__ __forceinline__ void stage_rc(int b, int& R, int& C) { const int st = b / 1024, sb = b % 1024, swz = sb ^ (((sb >> 9) & 1) << 5); R = (st >> 1) * 16 + swz / 64; C = (st & 1) * 32 + (swz % 64) / 2; }
__device__ __forceinline__ int perm32(int rho) { const int n = rho >> 4, i = rho & 15; return 8 * (i >> 2) + 4 * n + (i & 3); }

struct Unit { int pm, pn; };
struct Gemm { const bf16_t* A; const bf16_t* Bt; int lda, ldb, K, a_cpn; };

struct StaticOrder {
    int nM, nN, nwg, G, c;
    __device__ void init(int M_, int N_, int G_, int c_) { nM = M_ / BM; nN = N_ / BM; nwg = nM * nN; G = G_; c = c_; }
    __device__ bool next(int i, Unit& u) const {
        const long L = (long)i * G + c; if (L >= nwg) return false;
        int wgid = (int)L; { const int q = nwg / NXCD, r = nwg % NXCD, xcd = wgid % NXCD, off = wgid / NXCD; wgid = (xcd < r ? xcd * (q + 1) : r * (q + 1) + (xcd - r) * q) + off; }
        const int nig = WGM * nN, gid = wgid / nig, fm = gid * WGM, gsz = (nM - fm) < WGM ? (nM - fm) : WGM;
        u.pm = fm + ((wgid % nig) % gsz); u.pn = (wgid % nig) / gsz; return true;
    }
};


struct EpiIn {
    static constexpr bool PERM = true, AFTER_DRAIN = false;
    unsigned char* ws; const float* gq; const float* gk; LAS float* xl;
    __device__ __forceinline__ void operator()(f32x4 (&acc)[2][2][4][2], const Unit& u, int wr, int wc, int fr, int fq, int wid, int lane, int ui) const {
        bf16_t* out0 = (bf16_t*)(ws + WS_ACT); const float* rcos = (const float*)(ws + WS_COS); const float* rsin = (const float*)(ws + WS_SIN);
        const LAS float* rsl = xl + XL_BYTES / 4 + ui * 256;
        const int kind = u.pn >> 2, cb = (u.pn & 3) * 256;
        bf16_t* dst = out0 + (size_t)kind * ACT_ELEMS;
        const int row0 = u.pm * BM + wr * 64 + fr, colw = wc * 32 + 8 * fq;
#pragma unroll
        for (int ai = 0; ai < 2; ++ai)
#pragma unroll
            for (int m = 0; m < 4; ++m) {
                const float rs = rsl[ai * HALF + wr * 64 + m * 16 + fr];
#pragma unroll
                for (int bj = 0; bj < 2; ++bj)
#pragma unroll
                    for (int n = 0; n < 2; ++n) acc[ai][bj][m][n] *= rs;
                if (m & 1) __builtin_amdgcn_sched_barrier(0);
            }
        if (kind == 1 || kind == 2) {
            const float* g = (kind == 1) ? gq : gk;
#pragma unroll
            for (int ai = 0; ai < 2; ++ai)
#pragma unroll
                for (int m = 0; m < 4; ++m)
#pragma unroll
                    for (int bj = 0; bj < 2; ++bj) {
                        const f32x4 a = acc[ai][bj][m][0], b = acc[ai][bj][m][1];
                        float ss = (a[0] * a[0] + a[1] * a[1]) + (a[2] * a[2] + a[3] * a[3]) + (b[0] * b[0] + b[1] * b[1]) + (b[2] * b[2] + b[3] * b[3]);
                        ss = xor32_sum(xor16_sum(ss));
                        if (fq == 0) xl[((ai * HALF + wr * 64 + m * 16 + fr) * 2 + bj) * 4 + wc] = ss;
                    }
            LDS_BAR();
            const f32x4 g0 = *(const f32x4*)(g + colw), g1 = *(const f32x4*)(g + colw + 4);
            const float osc = (kind == 1) ? QSC : 1.0f;
            const float sgn = (fq < 2) ? -1.0f : 1.0f;
#pragma unroll
            for (int ai = 0; ai < 2; ++ai)
#pragma unroll
                for (int m = 0; m < 4; ++m) {
                    const int rt = ai * HALF + wr * 64 + m * 16 + fr, r = u.pm * BM + rt;
                    f32x4 c0, c1, s0, s1;
                    if (wc == 0) { const int j0 = 8 * (fq & 1); c0 = *(const f32x4*)(rcos + (size_t)r * 16 + j0); c1 = *(const f32x4*)(rcos + (size_t)r * 16 + j0 + 4);
                                   s0 = *(const f32x4*)(rsin + (size_t)r * 16 + j0); s1 = *(const f32x4*)(rsin + (size_t)r * 16 + j0 + 4); }
#pragma unroll
                    for (int bj = 0; bj < 2; ++bj) {
                        const f32x4 t4 = *(const LAS f32x4*)(xl + (rt * 2 + bj) * 4);
                        const float rn = __builtin_amdgcn_rsqf(((t4[0] + t4[1]) + (t4[2] + t4[3])) * (1.0f / 128.0f) + NORM_EPS);
                        f32x4 v0 = acc[ai][bj][m][0] * rn * g0, v1 = acc[ai][bj][m][1] * rn * g1;
                        if (wc == 0) {
                            f32x4 p0, p1;
#pragma unroll
                            for (int i = 0; i < 4; ++i) { p0[i] = xor32_get(v0[i], fq >> 1); p1[i] = xor32_get(v1[i], fq >> 1); }
                            v0 = v0 * c0 + (p0 * s0) * sgn; v1 = v1 * c1 + (p1 * s1) * sgn;
                        }
                        v0 *= osc; v1 *= osc;
                        *(u32x4*)(dst + (size_t)r * D + cb + bj * HALF + colw) = pack8(v0, v1);
                    }
                    __builtin_amdgcn_sched_barrier(0);
                }
        } else {
            const bool sg = kind >= 4;
#pragma unroll
            for (int ai = 0; ai < 2; ++ai)
#pragma unroll
                for (int m = 0; m < 4; ++m) {
                    const int r = row0 + ai * HALF + m * 16;
#pragma unroll
                    for (int bj = 0; bj < 2; ++bj) {
                        f32x4 v0 = acc[ai][bj][m][0], v1 = acc[ai][bj][m][1];
                        if (sg) {
#pragma unroll
                            for (int i = 0; i < 4; ++i) { v0[i] = sigmoidf_(v0[i]); v1[i] = sigmoidf_(v1[i]); }
                        }
                        *(u32x4*)(dst + (size_t)r * D + cb + bj * HALF + colw) = pack8(v0, v1);
                    }
                }
        }
    }
};

struct EpiSwiGLU {
    static constexpr bool PERM = true, AFTER_DRAIN = false;
    bf16_t* act; LAS float* xl;
    __device__ __forceinline__ void operator()(f32x4 (&acc)[2][2][4][2], const Unit& u, int wr, int wc, int fr, int fq, int wid, int lane, int ui) const {
        const int row0 = u.pm * BM + wr * 64 + fr, col = u.pn * HALF + wc * 32 + 8 * fq;
#pragma unroll
        for (int ai = 0; ai < 2; ++ai)
#pragma unroll
            for (int m = 0; m < 4; ++m) {
                const int r = row0 + ai * HALF + m * 16;
                const float rs = xl[XL_BYTES / 4 + ui * 256 + ai * HALF + wr * 64 + m * 16 + fr];
                f32x4 o[2];
#pragma unroll
                for (int n = 0; n < 2; ++n) {
                    const f32x4 gt = acc[ai][0][m][n] * rs, up = acc[ai][1][m][n] * rs;
#pragma unroll
                    for (int i = 0; i < 4; ++i) o[n][i] = gt[i] * sigmoidf_(gt[i]) * up[i];
                }
                *(u32x4*)(act + (size_t)r * FF + col) = pack8(o[0], o[1]);
            }
    }
};

struct EpiMerge {
    static constexpr bool PERM = true, AFTER_DRAIN = true;
    const bf16_t* sga; const bf16_t* sgb; const bf16_t* o0; const bf16_t* o1; const float* pscale; const float* subg; bf16_t* merged; float osc; LAS float* xl;
    __device__ __forceinline__ void operator()(f32x4 (&acc)[2][2][4][2], const Unit& u, int wr, int wc, int fr, int fq, int wid, int lane, int ui) const {
        const int row0 = u.pm * BM + wr * 64 + fr;
#pragma unroll
        for (int ai = 0; ai < 2; ++ai)
#pragma unroll
            for (int m = 0; m < 4; ++m) {
                float ss = 0.f;
#pragma unroll
                for (int bj = 0; bj < 2; ++bj) {
                    const size_t off = (size_t)(row0 + ai * HALF + m * 16) * D + u.pn * BM + bj * HALF + wc * 32 + 8 * fq;
                    f32x4 a0, a1, b0, b1; unpack8(*(const u32x4*)(o0 + off), a0, a1); unpack8(*(const u32x4*)(o1 + off), b0, b1);
                    const f32x4 d0 = a0 - b0, d1 = a1 - b1;
                    ss += (d0[0] * d0[0] + d0[1] * d0[1]) + (d0[2] * d0[2] + d0[3] * d0[3]) + (d1[0] * d1[0] + d1[1] * d1[1]) + (d1[2] * d1[2] + d1[3] * d1[3]);
                }
                ss = xor32_sum(xor16_sum(ss));
                if (fq == 0) xl[(ai * HALF + wr * 64 + m * 16 + fr) * 4 + wc] = ss;
            }
        LDS_BAR();
#pragma unroll
        for (int bj = 0; bj < 2; ++bj) {
            const int col = u.pn * BM + bj * HALF + wc * 32 + 8 * fq;
            const f32x4 ps0 = *(const f32x4*)(pscale + col), ps1 = *(const f32x4*)(pscale + col + 4);
            const f32x4 g0 = *(const f32x4*)(subg + (col & 255)), g1 = *(const f32x4*)(subg + (col & 255) + 4);
#pragma unroll
            for (int ai = 0; ai < 2; ++ai)
#pragma unroll
                for (int m = 0; m < 4; ++m) {
                    const int rt = ai * HALF + wr * 64 + m * 16 + fr;
                    const f32x4 t4 = *(const LAS f32x4*)(xl + rt * 4);
                    const float rn = __builtin_amdgcn_rsqf(((t4[0] + t4[1]) + (t4[2] + t4[3])) * (1.0f / 256.0f) + NORM_EPS) * osc;
                    const size_t off = (size_t)(u.pm * BM + rt) * D + col;
                    const u32x4 wa = *(const u32x4*)(sga + off), wb = *(const u32x4*)(sgb + off), w0 = *(const u32x4*)(o0 + off), w1 = *(const u32x4*)(o1 + off);
                    f32x4 a0, a1, b0, b1, x0, x1, y0, y1; unpack8(wa, a0, a1); unpack8(wb, b0, b1); unpack8(w0, x0, x1); unpack8(w1, y0, y1);
                    const f32x4 t0 = (x0 - y0) * g0 * rn, t1 = (x1 - y1) * g1 * rn;
                    const f32x4 r0 = a0 * (acc[ai][bj][m][0] * ps0) + b0 * t0, r1 = a1 * (acc[ai][bj][m][1] * ps1) + b1 * t1;
                    *(u32x4*)(merged + off) = pack8(r0, r1);
                }
        }
        LDS_BAR();
    }
};

__device__ __forceinline__ float swz_sum32(float v) {
    v += __uint_as_float((unsigned)__builtin_amdgcn_ds_swizzle((int)__float_as_uint(v), 0x041F));
    v += __uint_as_float((unsigned)__builtin_amdgcn_ds_swizzle((int)__float_as_uint(v), 0x081F));
    v += __uint_as_float((unsigned)__builtin_amdgcn_ds_swizzle((int)__float_as_uint(v), 0x101F));
    v += __uint_as_float((unsigned)__builtin_amdgcn_ds_swizzle((int)__float_as_uint(v), 0x201F));
    v += __uint_as_float((unsigned)__builtin_amdgcn_ds_swizzle((int)__float_as_uint(v), 0x401F));
    return v;
}
struct EpiRes {
    static constexpr bool PERM = false, AFTER_DRAIN = true;
    const float* res; float* out; bf16_t* xb; float* ssq; LAS unsigned char* lds;
    __device__ __forceinline__ void operator()(f32x4 (&acc)[2][2][4][2], const Unit& u, int wr, int wc, int fr, int fq, int wid, int lane, int ui) const {
        constexpr int RS = 1040;
#pragma unroll
        for (int ai = 0; ai < 2; ++ai) {
#pragma unroll
            for (int m = 0; m < 4; ++m)
#pragma unroll
                for (int bj = 0; bj < 2; ++bj)
#pragma unroll
                    for (int n = 0; n < 2; ++n)
                        *(LAS f32x4*)(lds + (wr * 64 + m * 16 + fr) * RS + (bj * HALF + wc * 32 + n * 16 + 4 * fq) * 4) = acc[ai][bj][m][n];
            LDS_BAR();
#pragma unroll 1
            for (int c = 0; c < 2; ++c) {
                f32x4 rv[8];
#pragma unroll
                for (int rr = 0; rr < 8; ++rr) { const size_t grow = (size_t)(u.pm * BM + ai * HALF + wid * 16 + c * 8 + rr); rv[rr] = *((const f32x4*)(res + grow * D + u.pn * BM) + lane); }
#pragma unroll
                for (int rr = 0; rr < 8; ++rr) {
                    const int rl = wid * 16 + c * 8 + rr; const size_t grow = (size_t)(u.pm * BM + ai * HALF + rl);
                    const f32x4 v = rv[rr] + *(const LAS f32x4*)(lds + rl * RS + lane * 16);
                    *((f32x4*)(out + grow * D + u.pn * BM) + lane) = v;
                    u32x2 w; w.x = cvt_pk_bf16(v[0], v[1]); w.y = cvt_pk_bf16(v[2], v[3]);
                    *((u32x2*)(xb + grow * D + u.pn * BM) + lane) = w;
                    float ss = (v[0] * v[0] + v[1] * v[1]) + (v[2] * v[2] + v[3] * v[3]);
                    ss = xor32_sum(swz_sum32(ss));
                    if (lane == 0) ssq[(size_t)u.pn * M + grow] = ss;
                }
            }
            LDS_BAR();
        }
    }
};

template <class Epi, bool ALIGN_EPI>
__device__ __forceinline__ void gemm_phase(LAS unsigned char* lds, const Gemm g, const StaticOrder& S, const Epi& E, int wv) {
    int tid_ = (wv << 6) | lane_id(); asm volatile("" : "+v"(tid_));
    const int tid = tid_, wid = __builtin_amdgcn_readfirstlane(tid >> 6), lane = tid & 63, wr = wid >> 2, wc = wid & 3, fr = lane & 15, fq = lane >> 4;
    const int K = g.K, nt = K / BK;
    unsigned voffA[2], voffB[2];
#pragma unroll
    for (int i = 0; i < 2; ++i) { int R, C; stage_rc(tid * 16 + i * 8192, R, C); const int Rb = Epi::PERM ? ((R & ~31) + perm32(R & 31)) : R;
        voffA[i] = (unsigned)(R * g.lda + C) * 2u; voffB[i] = (unsigned)(Rb * g.ldb + C) * 2u; }
    const size_t kstep = (size_t)(BK * 2);
    const size_t hstepA = (size_t)HALF * g.lda * 2, hstepB = (size_t)HALF * g.ldb * 2;
    const unsigned ldsw = (unsigned)wid * 1024u;
    const int aoff = lds_byte(wr * 64 + fr, fq * 8), boff = lds_byte(wc * 32 + fr, fq * 8);
#define PG8_SA(b, h) (((b) * 2 + (h)) * HTB)
#define PG8_SB(b, h) ((4 + (b) * 2 + (h)) * HTB)
#define PG8_STAGE(bufoff, gbase, voff) do { _Pragma("unroll") for (int _i = 0; _i < 2; ++_i) \
        __builtin_amdgcn_global_load_lds((const unsigned*)((const char*)(gbase) + (voff)[_i]), (LAS unsigned*)(lds + (bufoff) + ldsw + _i * 8192), 16, 0, 0); } while (0)
#define PG8_LDA(dst, b, h) do { _Pragma("unroll") for (int m = 0; m < 4; ++m) _Pragma("unroll") for (int k = 0; k < 2; ++k) dst[m][k] = *(const LAS bf16x8*)(lds + PG8_SA(b, h) + aoff + m * 2048 + k * 1024); } while (0)
#define PG8_LDB(dst, b, h) do { _Pragma("unroll") for (int n = 0; n < 2; ++n) _Pragma("unroll") for (int k = 0; k < 2; ++k) dst[n][k] = *(const LAS bf16x8*)(lds + PG8_SB(b, h) + boff + n * 2048 + k * 1024); } while (0)
#define PG8_MMA(ai, bj, At, Bt) do { __builtin_amdgcn_s_setprio(1); _Pragma("unroll") for (int m = 0; m < 4; ++m) _Pragma("unroll") for (int n = 0; n < 2; ++n) _Pragma("unroll") for (int k = 0; k < 2; ++k) \
        acc[ai][bj][m][n] = __builtin_amdgcn_mfma_f32_16x16x32_bf16(Bt[n][k], At[m][k], acc[ai][bj][m][n], 0, 0, 0); __builtin_amdgcn_s_setprio(0); } while (0)
#define PG8_WAIT_V(n) asm volatile("s_waitcnt vmcnt(" #n ")" ::: "memory")
#define PG8_WAIT_L(n) asm volatile("s_waitcnt lgkmcnt(" #n ")" ::: "memory")
#define PG8_BAR __builtin_amdgcn_s_barrier()
#define PG8_SCHED __builtin_amdgcn_sched_barrier(0)
#define PG8_UA(u_) ((const char*)g.A + ((size_t)(u_).pm * BM * g.lda + (size_t)(u_).pn * g.a_cpn) * 2)
#define PG8_UB(u_) ((const char*)g.Bt + (size_t)(u_).pn * BM * g.ldb * 2)
    Unit cur, nxt; int ui = 0;
    (void)S.next(0, cur);
    f32x4 acc[2][2][4][2];
#pragma unroll
    for (int a = 0; a < 2; ++a)
#pragma unroll
        for (int b = 0; b < 2; ++b)
#pragma unroll
            for (int m = 0; m < 4; ++m)
#pragma unroll
                for (int n = 0; n < 2; ++n) acc[a][b][m][n] = (f32x4){0.f, 0.f, 0.f, 0.f};
    bf16x8 At[4][2], B0[2][2], B1[2][2];
    const char* cA = PG8_UA(cur); const char* cB = PG8_UB(cur);
    PG8_STAGE(PG8_SB(0, 0), cB, voffB); PG8_STAGE(PG8_SB(0, 1), cB + hstepB, voffB); PG8_STAGE(PG8_SA(0, 0), cA, voffA); PG8_STAGE(PG8_SA(0, 1), cA + hstepA, voffA);
    if (wr == 1) PG8_BAR;
    PG8_WAIT_V(2); PG8_BAR;
    PG8_STAGE(PG8_SB(1, 0), cB + kstep, voffB); PG8_STAGE(PG8_SA(1, 0), cA + kstep, voffA); PG8_STAGE(PG8_SB(1, 1), cB + hstepB + kstep, voffB);
    PG8_WAIT_V(6); PG8_BAR;
    for (;;) {
        const bool has_next = S.next(ui + 1, nxt);
        const char* nA = has_next ? PG8_UA(nxt) : cA; const char* nB = has_next ? PG8_UB(nxt) : cB;
        for (int t = 0; t < nt; t += 2) {
            const bool last = (t == nt - 2);
            const char* a1 = cA + (size_t)(t + 1) * kstep;
            const char* a2 = last ? nA : cA + (size_t)(t + 2) * kstep; const char* b2 = last ? nB : cB + (size_t)(t + 2) * kstep;
            const char* a3 = a2 + kstep; const char* b3 = b2 + kstep;
            PG8_LDB(B0, 0, 0); PG8_LDB(B1, 0, 1); PG8_SCHED; PG8_LDA(At, 0, 0); PG8_STAGE(PG8_SA(1, 1), a1 + hstepA, voffA);
            PG8_WAIT_V(8); PG8_WAIT_L(0); PG8_BAR; PG8_MMA(0, 0, At, B0); PG8_MMA(0, 1, At, B1); PG8_BAR; PG8_SCHED;
            PG8_LDA(At, 0, 1); PG8_STAGE(PG8_SB(0, 0), b2, voffB); PG8_STAGE(PG8_SB(0, 1), b2 + hstepB, voffB); PG8_STAGE(PG8_SA(0, 0), a2, voffA);
            PG8_WAIT_V(8); PG8_WAIT_L(0); PG8_BAR; PG8_MMA(1, 0, At, B0); PG8_MMA(1, 1, At, B1); PG8_BAR; PG8_SCHED;
            PG8_LDB(B0, 1, 0); PG8_LDB(B1, 1, 1); PG8_SCHED; PG8_LDA(At, 1, 0); PG8_STAGE(PG8_SA(0, 1), a2 + hstepA, voffA);
            PG8_WAIT_V(8); PG8_WAIT_L(0); PG8_BAR; PG8_MMA(0, 0, At, B0); PG8_MMA(0, 1, At, B1); PG8_BAR; PG8_SCHED;
            PG8_LDA(At, 1, 1); PG8_STAGE(PG8_SB(1, 0), b3, voffB); PG8_STAGE(PG8_SB(1, 1), b3 + hstepB, voffB); PG8_STAGE(PG8_SA(1, 0), a3, voffA);
            PG8_WAIT_V(8); PG8_WAIT_L(0); PG8_BAR; PG8_MMA(1, 0, At, B0); PG8_MMA(1, 1, At, B1); PG8_BAR; PG8_SCHED;
        }
        if constexpr (ALIGN_EPI) { if (wr == 0) PG8_BAR; }
        if constexpr (!Epi::AFTER_DRAIN) { E(acc, cur, wr, wc, fr, fq, wid, lane, ui); }
        if (!has_next) break;
#pragma unroll
        for (int a = 0; a < 2; ++a)
#pragma unroll
            for (int b = 0; b < 2; ++b)
#pragma unroll
                for (int m = 0; m < 4; ++m)
#pragma unroll
                    for (int n = 0; n < 2; ++n) acc[a][b][m][n] = (f32x4){0.f, 0.f, 0.f, 0.f};
        cur = nxt; cA = nA; cB = nB; ++ui;
        if constexpr (ALIGN_EPI) { if (wr == 1) PG8_BAR; }
    }
    PG8_WAIT_V(0);
    if constexpr (!ALIGN_EPI) { if (wr == 0) PG8_BAR; }
    PG8_BAR;
    if constexpr (Epi::AFTER_DRAIN) { E(acc, cur, wr, wc, fr, fq, wid, lane, ui); }
#undef PG8_SA
#undef PG8_SB
#undef PG8_STAGE
#undef PG8_LDA
#undef PG8_LDB
#undef PG8_MMA
#undef PG8_WAIT_V
#undef PG8_WAIT_L
#undef PG8_BAR
#undef PG8_SCHED
#undef PG8_UA
#undef PG8_UB
}
}

namespace att {
typedef LAS const char* lds_cptr;
typedef short v4i16_t __attribute__((ext_vector_type(4)));
constexpr int STAGE = 65536, KV = 64;
__device__ __forceinline__ void glds16(const void* gsrc, unsigned lds_dst) { unsigned keep;
    asm volatile("s_mov_b32 %0, m0\n\ts_mov_b32 m0, %2\n\ts_nop 0\n\tglobal_load_lds_dwordx4 %1, off\n\ts_mov_b32 m0, %0" : "=&s"(keep) : "v"(gsrc), "s"(lds_dst) : "memory"); }
__device__ __forceinline__ v4i16_t vtr(lds_cptr p) { return __builtin_amdgcn_ds_read_tr16_b64_v4i16((LAS v4i16_t*)p); }
typedef float f32x2_t __attribute__((ext_vector_type(2))); typedef __bf16 bf16x2_t __attribute__((ext_vector_type(2)));
__device__ __forceinline__ unsigned cvtpk_s(float lo, float hi) { f32x2_t v = {lo, hi}; bf16x2_t b = __builtin_convertvector(v, bf16x2_t); return __builtin_bit_cast(unsigned, b); }
#define ATT_WAIT_BAR() asm volatile("s_waitcnt vmcnt(0) lgkmcnt(0)\n\ts_barrier" ::: "memory")

template <int IDX> __device__ __forceinline__ void dma_piece(unsigned kvo, unsigned vvo, const char* kbn, const char* vbn, unsigned kdn, unsigned vdn) {
    unsigned keep, tv;
    if constexpr (IDX < 4) {
        constexpr int dl = (IDX & 1) * 16 + (IDX >> 1) * 256; const unsigned dst = kdn + (IDX & 1) * 0x400 + (IDX >> 1) * 0x4000;
        asm volatile("s_mov_b32 %0, m0\n\ts_mov_b32 m0, %3\n\tv_add_u32 %1, %4, %2\n\ts_nop 0\n\tglobal_load_lds_dwordx4 %1, %5\n\ts_mov_b32 m0, %0"
                     : "=&s"(keep), "=&v"(tv) : "v"(kvo), "s"(dst), "i"(dl), "s"(kbn) : "memory");
    } else {
        constexpr int dl = (IDX - 4) * 0x8000; const unsigned dst = vdn + (IDX - 4) * 0x400;
        asm volatile("s_mov_b32 %0, m0\n\ts_mov_b32 m0, %3\n\tv_add_u32 %1, %4, %2\n\ts_nop 0\n\tglobal_load_lds_dwordx4 %1, %5\n\ts_mov_b32 m0, %0"
                     : "=&s"(keep), "=&v"(tv) : "v"(vvo), "s"(dst), "i"(dl), "s"(vbn) : "memory");
    }
}
template <bool SHIFT> __device__ __forceinline__ void attn_item(int h, int qb, const bf16_t* Q, const bf16_t* Kt, const bf16_t* V, bf16_t* O, char* shm, float lam, float osc, const float* subg, float cshift, int wv) {
    int tid_ = (wv << 6) | lane_id(); asm volatile("" : "+v"(tid_));
    const int tid = tid_, lane = tid & 63, r32 = lane & 31, hi = lane >> 5;
    const int wid = __builtin_amdgcn_readfirstlane(tid >> 6), comp = wid >> 2, w = wid & 3;
    const int q0 = qb * 128;
    const unsigned lds0 = (unsigned)(uintptr_t)shm;
    const lds_cptr shm3 = (lds_cptr)shm;
    const unsigned kvo = (unsigned)(lane * D + wid * 16) * 2u;
    const unsigned vvo = (unsigned)((lane >> 2) * D + wid * 32 + (lane & 3) * 8) * 2u;
    const char* kbase = (const char*)(Kt + h * 256);
    const char* vbase = (const char*)(V + h * 256);
    const int NT = 2 * qb + 2, NTw = 2 * qb + 1 + (w >> 1);
#define ATT_DMA(t, st) do { const char* kb_ = kbase + (size_t)(t) * (KV * D * 2); const char* vb_ = vbase + (size_t)(t) * (KV * D * 2); \
        const unsigned kd_ = (unsigned)__builtin_amdgcn_readfirstlane(lds0 + (st) + wid * 2048), vd_ = (unsigned)__builtin_amdgcn_readfirstlane(lds0 + (st) + 32768 + wid * 4096); \
        unsigned keep_, tv_; \
        asm volatile("s_nop 4\n\ts_mov_b32 %0, m0\n\ts_mov_b32 m0, %4\n\ts_nop 0\n\t" \
                     "global_load_lds_dwordx4 %2, %6\n\tv_add_u32 %1, 16, %2\n\ts_add_u32 m0, m0, 0x400\n\ts_nop 0\n\t" \
                     "global_load_lds_dwordx4 %1, %6\n\tv_add_u32 %1, 0x100, %2\n\ts_add_u32 m0, m0, 0x3c00\n\ts_nop 0\n\t" \
                     "global_load_lds_dwordx4 %1, %6\n\tv_add_u32 %1, 0x110, %2\n\ts_add_u32 m0, m0, 0x400\n\ts_nop 0\n\t" \
                     "global_load_lds_dwordx4 %1, %6\n\ts_mov_b32 m0, %5\n\ts_nop 0\n\t" \
                     "global_load_lds_dwordx4 %3, %7\n\tv_add_u32 %1, 0x8000, %3\n\ts_add_u32 m0, m0, 0x400\n\ts_nop 0\n\t" \
                     "global_load_lds_dwordx4 %1, %7\n\tv_add_u32 %1, 0x8000, %1\n\ts_add_u32 m0, m0, 0x400\n\ts_nop 0\n\t" \
                     "global_load_lds_dwordx4 %1, %7\n\tv_add_u32 %1, 0x8000, %1\n\ts_add_u32 m0, m0, 0x400\n\ts_nop 0\n\t" \
                     "global_load_lds_dwordx4 %1, %7\n\ts_mov_b32 m0, %0" \
                     : "=&s"(keep_), "=&v"(tv_) : "v"(kvo), "v"(vvo), "s"(kd_), "s"(vd_), "s"(kb_), "s"(vb_) : "memory", "scc"); } while (0)
    ATT_DMA(0, 0);
    bf16x8 qr[8];
    { const bf16_t* qp = Q + (size_t)(q0 + 32 * w + r32) * D + h * 256 + comp * 128 + hi * 8;
#pragma unroll
      for (int ks = 0; ks < 8; ++ks) qr[ks] = *(const bf16x8*)(qp + ks * 16); }
    f32x16 o[8];
#pragma unroll
    for (int d0 = 0; d0 < 8; ++d0) o[d0] = f32x16{};
    float lsum = 0.f;
    const int koff = comp * 16384 + hi * 1024 + r32 * 16;
    const int voff = 32768 + ((r32 >> 4) & 1) * 32 + (r32 & 3) * 8 + (4 * hi + ((r32 & 15) >> 2)) * 64;
#define ATT_SB() __builtin_amdgcn_sched_barrier(0)
    for (int t = 0; t < NT; ++t) {
        const int st = (t & 1) * STAGE;
        ATT_WAIT_BAR();
        const bool has_next = (t + 1 < NT);
        const char* kbn = kbase + (size_t)(t + 1) * (KV * D * 2); const char* vbn = vbase + (size_t)(t + 1) * (KV * D * 2);
        const unsigned kdn = (unsigned)__builtin_amdgcn_readfirstlane(lds0 + (STAGE - st) + wid * 2048), vdn = (unsigned)__builtin_amdgcn_readfirstlane(lds0 + (STAGE - st) + 32768 + wid * 4096);
        if (t >= NTw) { if (has_next) ATT_DMA(t + 1, STAGE - st); }
        if (t < NTw) {
            const lds_cptr kb = shm3 + st + koff;
            const lds_cptr vb = shm3 + st + voff;
#define ATT_KFRAG(i_) (*(const LAS bf16x8*)(kb + ((i_) & 7) * 2048 + ((i_) >> 3) * 512))
#define ATT_VFRAG(dst, j_) do { const v4i16_t lo_ = vtr(vb + ((j_) & 7) * 4096 + ((j_) >> 3) * 1024), hh_ = vtr(vb + ((j_) & 7) * 4096 + ((j_) >> 3) * 1024 + 512); \
        dst = (bf16x8){lo_[0], lo_[1], lo_[2], lo_[3], hh_[0], hh_[1], hh_[2], hh_[3]}; } while (0)
            f32x16 s0, s1;
            u32x4 pw[4];
            bf16x8 kf[3], vf[3];
            float sa = 0.f, sb = 0.f;
            kf[0] = ATT_KFRAG(0); kf[1] = ATT_KFRAG(1);
#pragma unroll
            for (int i = 0; i < 16; ++i) {
                if (i + 2 < 16) kf[(i + 2) % 3] = ATT_KFRAG(i + 2);
                if ((i & 3) == 2) { if (has_next) { switch (i >> 2) {
                    case 0: dma_piece<0>(kvo, vvo, kbn, vbn, kdn, vdn); break; case 1: dma_piece<1>(kvo, vvo, kbn, vbn, kdn, vdn); break;
                    case 2: dma_piece<2>(kvo, vvo, kbn, vbn, kdn, vdn); break; default: dma_piece<3>(kvo, vvo, kbn, vbn, kdn, vdn); break; } } }
                if (i == 14) ATT_VFRAG(vf[0], 0);
                if (i == 15) ATT_VFRAG(vf[1], 1);
                if (i < 8) {
                    if (i == 0) s0 = __builtin_amdgcn_mfma_f32_32x32x16_bf16(kf[0], qr[0], f32x16{}, 0, 0, 0);
                    else s0 = __builtin_amdgcn_mfma_f32_32x32x16_bf16(kf[i % 3], qr[i], s0, 0, 0, 0);
                } else {
                    const int ks = i - 8;
                    if (ks == 0) s1 = __builtin_amdgcn_mfma_f32_32x32x16_bf16(kf[i % 3], qr[0], f32x16{}, 0, 0, 0);
                    else s1 = __builtin_amdgcn_mfma_f32_32x32x16_bf16(kf[i % 3], qr[ks], s1, 0, 0, 0);
                    s0[2 * ks] = __builtin_amdgcn_exp2f(SHIFT ? s0[2 * ks] - cshift : s0[2 * ks]); s0[2 * ks + 1] = __builtin_amdgcn_exp2f(SHIFT ? s0[2 * ks + 1] - cshift : s0[2 * ks + 1]);
                    if (ks >= 1) { sa += s0[2 * ks - 2] + s0[2 * ks - 1]; pw[(ks - 1) >> 2][(ks - 1) & 3] = cvtpk_s(s0[2 * ks - 2], s0[2 * ks - 1]); }
                }
                ATT_SB();
            }
#pragma unroll
            for (int j = 0; j < 32; ++j) {
                if (j + 2 < 32) ATT_VFRAG(vf[(j + 2) % 3], j + 2);
                if ((j & 3) == 1 && j < 16) { if (has_next) { switch (4 + (j >> 2)) {
                    case 0: dma_piece<0>(kvo, vvo, kbn, vbn, kdn, vdn); break; case 1: dma_piece<1>(kvo, vvo, kbn, vbn, kdn, vdn); break;
                    case 2: dma_piece<2>(kvo, vvo, kbn, vbn, kdn, vdn); break; case 3: dma_piece<3>(kvo, vvo, kbn, vbn, kdn, vdn); break;
                    case 4: dma_piece<4>(kvo, vvo, kbn, vbn, kdn, vdn); break; case 5: dma_piece<5>(kvo, vvo, kbn, vbn, kdn, vdn); break;
                    case 6: dma_piece<6>(kvo, vvo, kbn, vbn, kdn, vdn); break; default: dma_piece<7>(kvo, vvo, kbn, vbn, kdn, vdn); break; } } }
                o[j & 7] = __builtin_amdgcn_mfma_f32_32x32x16_bf16(vf[j % 3], __builtin_bit_cast(bf16x8, pw[j >> 3]), o[j & 7], 0, 0, 0);
                if (j == 0) { sa += s0[14] + s0[15]; pw[1][3] = cvtpk_s(s0[14], s0[15]); }
                if (j < 16) s1[j] = __builtin_amdgcn_exp2f(SHIFT ? s1[j] - cshift : s1[j]);
                if (j >= 1 && j < 17) sb += s1[j - 1];
                if (j >= 2 && j < 18 && !(j & 1)) pw[2 + ((j - 2) >> 3)][((j - 2) & 7) >> 1] = cvtpk_s(s1[j - 2], s1[j - 1]);
                ATT_SB();
            }
            lsum += sa + sb;
#undef ATT_KFRAG
#undef ATT_VFRAG
        }
    }
#undef ATT_SB
    const float l = xor32_sum(lsum);
    const float inv = 1.0f / l;
    ATT_WAIT_BAR();
    LAS f32x4* X = (LAS f32x4*)shm;
    if (comp == 1) {
        const float sc = inv * lam;
#pragma unroll
        for (int d0 = 0; d0 < 8; ++d0)
#pragma unroll
            for (int r4 = 0; r4 < 4; ++r4)
                { X[(w * 32 + d0 * 4 + r4) * 64 + lane] = (f32x4){o[d0][4 * r4] * sc, o[d0][4 * r4 + 1] * sc, o[d0][4 * r4 + 2] * sc, o[d0][4 * r4 + 3] * sc}; __builtin_amdgcn_sched_barrier(0); }
    }
    ATT_WAIT_BAR();
    if (comp == 0) {
        float ss = 0.f;
#pragma unroll
        for (int d0 = 0; d0 < 8; ++d0)
#pragma unroll
            for (int r4 = 0; r4 < 4; ++r4) {
                const f32x4 x = X[(w * 32 + d0 * 4 + r4) * 64 + lane];
#pragma unroll
                for (int i = 0; i < 4; ++i) { const float dd = o[d0][4 * r4 + i] * inv - x[i]; o[d0][4 * r4 + i] = dd; ss += dd * dd; }
                if (r4 == 3) __builtin_amdgcn_sched_barrier(0);
            }
        ss = xor32_sum(ss);
        const float rstd = __builtin_amdgcn_rsqf(ss * (1.0f / 256.0f) + NORM_EPS) * osc;
        bf16_t* orow = O + (size_t)(q0 + 32 * w + r32) * D + h * 256 + 4 * hi;
#pragma unroll
        for (int d0 = 0; d0 < 8; ++d0)
#pragma unroll
            for (int r4 = 0; r4 < 4; ++r4) {
                const int dv = 32 * d0 + 8 * r4;
                const f32x4 g4 = *(const f32x4*)(subg + dv + 4 * hi);
                u32x2 wv; wv.x = cvt_pk_bf16(o[d0][4 * r4] * rstd * g4[0], o[d0][4 * r4 + 1] * rstd * g4[1]); wv.y = cvt_pk_bf16(o[d0][4 * r4 + 2] * rstd * g4[2], o[d0][4 * r4 + 3] * rstd * g4[3]);
                *(u32x2*)(orow + dv) = wv;
                if (r4 == 3) __builtin_amdgcn_sched_barrier(0);
            }
    }
    ATT_WAIT_BAR();
#undef ATT_DMA
}

template <int IDX> __device__ __forceinline__ void dma_piece2(unsigned kvo, unsigned vvo, const char* kbn, const char* vbn, unsigned kdn, unsigned vdn) {
    unsigned keep, tv;
    if constexpr (IDX < 2) {
        constexpr int dl = IDX * 16; const unsigned dst = kdn + IDX * 0x400;
        asm volatile("s_mov_b32 %0, m0\n\ts_mov_b32 m0, %3\n\tv_add_u32 %1, %4, %2\n\ts_nop 0\n\tglobal_load_lds_dwordx4 %1, %5\n\ts_mov_b32 m0, %0"
                     : "=&s"(keep), "=&v"(tv) : "v"(kvo), "s"(dst), "i"(dl), "s"(kbn) : "memory");
    } else {
        constexpr int dl = (IDX - 2) * 0x8000; const unsigned dst = vdn + (IDX - 2) * 0x400;
        asm volatile("s_mov_b32 %0, m0\n\ts_mov_b32 m0, %3\n\tv_add_u32 %1, %4, %2\n\ts_nop 0\n\tglobal_load_lds_dwordx4 %1, %5\n\ts_mov_b32 m0, %0"
                     : "=&s"(keep), "=&v"(tv) : "v"(vvo), "s"(dst), "i"(dl), "s"(vbn) : "memory");
    }
}
template <bool SHIFT, bool LATE> __device__ __forceinline__ void attn_item2(int h, int comp, int qb, const bf16_t* Q, const bf16_t* Kt, const bf16_t* V, bf16_t* O, char* shm, float oscale, float cshift, int wv) {
    constexpr int STG = 49152, VOFF = 16384;
    int tid_ = (wv << 6) | lane_id(); asm volatile("" : "+v"(tid_));
    const int tid = tid_, lane = tid & 63, r32 = lane & 31, hi = lane >> 5;
    const int wid = __builtin_amdgcn_readfirstlane(tid >> 6);
    const int q0 = qb * 256;
    const unsigned lds0 = (unsigned)(uintptr_t)shm;
    const lds_cptr shm3 = (lds_cptr)shm;
    const unsigned kvo = (unsigned)(lane * D + wid * 16) * 2u;
    const unsigned vvo = (unsigned)((lane >> 2) * D + wid * 32 + (lane & 3) * 8) * 2u;
    const char* kbase = (const char*)(Kt + h * 256 + comp * 128);
    const char* vbase = (const char*)(V + h * 256);
    const int NT = 4 * qb + 4, NTw = 4 * qb + 1 + (wv >> 1);
    {
        const unsigned kd0 = (unsigned)__builtin_amdgcn_readfirstlane(lds0 + wid * 2048), vd0 = (unsigned)__builtin_amdgcn_readfirstlane(lds0 + VOFF + wid * 4096);
        dma_piece2<0>(kvo, vvo, kbase, vbase, kd0, vd0); dma_piece2<1>(kvo, vvo, kbase, vbase, kd0, vd0); dma_piece2<2>(kvo, vvo, kbase, vbase, kd0, vd0);
        dma_piece2<3>(kvo, vvo, kbase, vbase, kd0, vd0); dma_piece2<4>(kvo, vvo, kbase, vbase, kd0, vd0); dma_piece2<5>(kvo, vvo, kbase, vbase, kd0, vd0);
    }
    bf16x8 qr[8];
    { const bf16_t* qp = Q + (size_t)(q0 + 32 * wid + r32) * D + h * 256 + comp * 128 + hi * 8;
#pragma unroll
      for (int ks = 0; ks < 8; ++ks) qr[ks] = *(const bf16x8*)(qp + ks * 16); }
    f32x16 o[8];
#pragma unroll
    for (int d0 = 0; d0 < 8; ++d0) o[d0] = f32x16{};
    float lsum = 0.f;
    const int koff = hi * 1024 + r32 * 16;
    const int voff = VOFF + ((r32 >> 4) & 1) * 32 + (r32 & 3) * 8 + (4 * hi + ((r32 & 15) >> 2)) * 64;
#define ATT_SB() __builtin_amdgcn_sched_barrier(0)
#define ATT_KFRAG(i_) (*(const LAS bf16x8*)(kb + ((i_) & 7) * 2048 + ((i_) >> 3) * 512))
#define ATT_VFRAG(dst, vb_, j_) do { const v4i16_t lo_ = vtr((vb_) + ((j_) & 7) * 4096 + ((j_) >> 3) * 1024), hh_ = vtr((vb_) + ((j_) & 7) * 4096 + ((j_) >> 3) * 1024 + 512); \
        dst = (bf16x8){lo_[0], lo_[1], lo_[2], lo_[3], hh_[0], hh_[1], hh_[2], hh_[3]}; } while (0)
#define ATT_P2(ix) dma_piece2<ix>(kvo, vvo, kbn, vbn, kdn, vdn)
#define ATT_QK_PVA(PRE) do { \
            const lds_cptr kb = shm3 + st + koff; const lds_cptr vb = shm3 + st + voff; \
            f32x16 s0, s1; float sa = 0.f, sb = 0.f; bf16x8 kf[3]; \
            kf[0] = ATT_KFRAG(0); kf[1] = ATT_KFRAG(1); \
            _Pragma("unroll") for (int i = 0; i < 16; ++i) { \
                if (i + 2 < 16) kf[(i + 2) % 3] = ATT_KFRAG(i + 2); \
                if (i == 14) ATT_VFRAG(vf[0], vb, 0); \
                if (i == 15) ATT_VFRAG(vf[1], vb, 1); \
                if (i < 8) { \
                    if (i == 0) s0 = __builtin_amdgcn_mfma_f32_32x32x16_bf16(kf[0], qr[0], f32x16{}, 0, 0, 0); \
                    else s0 = __builtin_amdgcn_mfma_f32_32x32x16_bf16(kf[i % 3], qr[i], s0, 0, 0, 0); \
                } else { \
                    const int ks = i - 8; \
                    if (ks == 0) s1 = __builtin_amdgcn_mfma_f32_32x32x16_bf16(kf[i % 3], qr[0], f32x16{}, 0, 0, 0); \
                    else s1 = __builtin_amdgcn_mfma_f32_32x32x16_bf16(kf[i % 3], qr[ks], s1, 0, 0, 0); \
                    s0[2 * ks] = __builtin_amdgcn_exp2f(SHIFT ? s0[2 * ks] - cshift : s0[2 * ks]); s0[2 * ks + 1] = __builtin_amdgcn_exp2f(SHIFT ? s0[2 * ks + 1] - cshift : s0[2 * ks + 1]); \
                    if (ks >= 1) { sa += s0[2 * ks - 2] + s0[2 * ks - 1]; pw[(ks - 1) >> 2][(ks - 1) & 3] = cvtpk_s(s0[2 * ks - 2], s0[2 * ks - 1]); } \
                } \
                ATT_SB(); \
            } \
            _Pragma("unroll") for (int j = 0; j < 16; ++j) { \
                if (j + 2 < 16 || (PRE)) ATT_VFRAG(vf[(j + 2) % 3], vb, j + 2); \
                if (j == 1) { if (has_next) ATT_P2(0); } \
                if (j == 3) { if (has_next) ATT_P2(1); } \
                if (j == 6) { if (has_next) ATT_P2(2); } \
                if (j == 8) { if (has_next) ATT_P2(3); } \
                if (j == 11) { if (has_next) ATT_P2(4); } \
                if (j == 13) { if (has_next) ATT_P2(5); } \
                o[j & 7] = __builtin_amdgcn_mfma_f32_32x32x16_bf16(vf[j % 3], __builtin_bit_cast(bf16x8, pw[j >> 3]), o[j & 7], 0, 0, 0); \
                if (j == 0) { sa += s0[14] + s0[15]; pw[1][3] = cvtpk_s(s0[14], s0[15]); } \
                s1[j] = __builtin_amdgcn_exp2f(SHIFT ? s1[j] - cshift : s1[j]); \
                if (j >= 1) sb += s1[j - 1]; \
                if (j >= 2 && !(j & 1)) pw[2 + ((j - 2) >> 3)][((j - 2) & 7) >> 1] = cvtpk_s(s1[j - 2], s1[j - 1]); \
                ATT_SB(); \
            } \
            sb += s1[15]; pw[3][3] = cvtpk_s(s1[14], s1[15]); \
            lsum += sa + sb; \
            ATT_SB(); \
        } while (0)
#define ATT_PVB(vb_, PRO) do { \
            if (PRO) { ATT_VFRAG(vf[16 % 3], (vb_), 16); ATT_VFRAG(vf[17 % 3], (vb_), 17); } \
            __builtin_amdgcn_s_setprio(1);        \
            _Pragma("unroll") for (int j = 16; j < 32; ++j) { \
                if (j + 2 < 32) ATT_VFRAG(vf[(j + 2) % 3], (vb_), j + 2); \
                o[j & 7] = __builtin_amdgcn_mfma_f32_32x32x16_bf16(vf[j % 3], __builtin_bit_cast(bf16x8, pw[j >> 3]), o[j & 7], 0, 0, 0); \
                ATT_SB(); \
            } \
            __builtin_amdgcn_s_setprio(0); \
        } while (0)
    u32x4 pw[4];
    bf16x8 vf[3];
    constexpr bool late = LATE;
    int st = 0, stp = 2 * STG, stn = STG;
    for (int t = 0; t < NT; ++t) {
        ATT_WAIT_BAR();
        const bool has_next = (t + 1 < NT);
        const char* kbn = kbase + (size_t)(t + 1) * (KV * D * 2); const char* vbn = vbase + (size_t)(t + 1) * (KV * D * 2);
        const unsigned kdn = (unsigned)__builtin_amdgcn_readfirstlane(lds0 + stn + wid * 2048), vdn = (unsigned)__builtin_amdgcn_readfirstlane(lds0 + stn + VOFF + wid * 4096);
        if (late) { if (t >= 1 && t - 1 < NTw) ATT_PVB(shm3 + stp + voff, true); }
        if (t < NTw) ATT_QK_PVA(false);
        else if (has_next) { ATT_P2(0); ATT_P2(1); ATT_P2(2); ATT_P2(3); ATT_P2(4); ATT_P2(5); }
        if (!late) { if (t < NTw) ATT_PVB(shm3 + st + voff, true); }
        stp = st; st = stn; stn = (stn == 2 * STG) ? 0 : stn + STG;
    }
    if (late) { if (NT - 1 < NTw) ATT_PVB(shm3 + stp + voff, true); }
#undef ATT_SB
#undef ATT_KFRAG
#undef ATT_VFRAG
#undef ATT_P2
#undef ATT_QK_PVA
#undef ATT_PVB
    const float sc = oscale / xor32_sum(lsum);
    ATT_WAIT_BAR();
    LAS unsigned char* stg = (LAS unsigned char*)shm + wid * 16896;
#pragma unroll
    for (int d0 = 0; d0 < 8; ++d0)
#pragma unroll
        for (int r4 = 0; r4 < 4; ++r4) {
            const int dv = 32 * d0 + 8 * r4 + 4 * hi;
            u32x2 wv2; wv2.x = cvt_pk_bf16(o[d0][4 * r4] * sc, o[d0][4 * r4 + 1] * sc); wv2.y = cvt_pk_bf16(o[d0][4 * r4 + 2] * sc, o[d0][4 * r4 + 3] * sc);
            *(LAS u32x2*)(stg + r32 * 528 + dv * 2) = wv2;
            if (r4 == 3) __builtin_amdgcn_sched_barrier(0);
        }
    asm volatile("s_waitcnt lgkmcnt(0)" ::: "memory");
    bf16_t* obase = O + (size_t)(q0 + 32 * wid) * D + h * 256 + (lane & 31) * 8;
#pragma unroll
    for (int i = 0; i < 16; ++i) {
        const int row = 2 * i + (lane >> 5);
        const u32x4 v = *(const LAS u32x4*)(stg + row * 528 + (lane & 31) * 16);
        *(u32x4*)(obase + (size_t)row * D) = v;
    }
    ATT_WAIT_BAR();
}
}

struct Args { const float* in[16]; float* out; unsigned char* ws; float invf[16]; };

__device__ __forceinline__ float wave_sum(float v) {
#pragma unroll
    for (int o = 1; o < 64; o <<= 1) v += __shfl_xor(v, o);
    return v;
}
__device__ __forceinline__ float wave_max(float v) {
#pragma unroll
    for (int o = 1; o < 64; o <<= 1) v = fmaxf(v, __shfl_xor(v, o));
    return v;
}
__device__ __forceinline__ unsigned f2bf(float f) { unsigned u = __builtin_bit_cast(unsigned, f); return (u + 0x7fffu + ((u >> 16) & 1u)) >> 16; }
__device__ __forceinline__ unsigned pk2(float lo, float hi) { return f2bf(lo) | (f2bf(hi) << 16); }

__device__ __forceinline__ void p0_transpose_item(const float* W, int K, int N, bf16_t* WT, int dest_row0, const float* gk, LAS float* scr, int k0, int n0, int lane) {
    float wv_[32];
    const float* wp = W + (size_t)(k0 + (lane >> 5)) * N + n0 + (lane & 31);
#pragma unroll
    for (int i = 0; i < 32; ++i) wv_[i] = wp[(size_t)(2 * i) * N];
    if (gk) {
#pragma unroll
        for (int i = 0; i < 32; ++i) wv_[i] *= gk[k0 + 2 * i + (lane >> 5)];
    }
#pragma unroll
    for (int i = 0; i < 32; ++i) scr[(2 * i + (lane >> 5)) * 33 + (lane & 31)] = wv_[i];
    asm volatile("s_waitcnt lgkmcnt(0)" ::: "memory");
    const int c = lane & 7;
#pragma unroll
    for (int j = 0; j < 4; ++j) { const int n = (lane >> 3) + 8 * j; const LAS float* s = scr + (8 * c) * 33 + n;
        u32x4 o; o.x = cvt_pk_bf16(s[0 * 33], s[1 * 33]); o.y = cvt_pk_bf16(s[2 * 33], s[3 * 33]); o.z = cvt_pk_bf16(s[4 * 33], s[5 * 33]); o.w = cvt_pk_bf16(s[6 * 33], s[7 * 33]);
        *(u32x4*)(WT + (size_t)(dest_row0 + n) * K + k0 + 8 * c) = o; }
    asm volatile("s_waitcnt lgkmcnt(0)" ::: "memory");
}

__device__ __forceinline__ void sincos_d(float angf, float& sn, float& cs) {
    const double a = (double)angf;
    const double n = rint(a * 0.63661977236758134308);
    double r = fma(-n, 1.57079632679489655800, a); r = fma(-n, 6.12323399573676603587e-17, r);
    const int q = ((int)n) & 3;
    const double r2 = r * r;
    const double sp = r * (1.0 + r2 * (-1.0 / 6 + r2 * (1.0 / 120 + r2 * (-1.0 / 5040 + r2 * (1.0 / 362880 + r2 * (-1.0 / 39916800 + r2 * (1.0 / 6227020800.0)))))));
    const double cp = 1.0 + r2 * (-0.5 + r2 * (1.0 / 24 + r2 * (-1.0 / 720 + r2 * (1.0 / 40320 + r2 * (-1.0 / 3628800 + r2 * (1.0 / 479001600.0 + r2 * (-1.0 / 87178291200.0)))))));
    const double s_ = (q == 0) ? sp : (q == 1) ? cp : (q == 2) ? -sp : -cp;
    const double c_ = (q == 0) ? cp : (q == 1) ? -sp : (q == 2) ? -cp : sp;
    sn = (float)s_; cs = (float)c_;
}

__device__ __forceinline__ void pooled_tile(const bf16_t* up, bf16_t* pooled, int pm, int g, int tid) {
    asm volatile("" : "+v"(tid));
    const int col = 256 * g + 8 * (tid & 31), wdw = 2 << g, t0 = 256 * pm + 16 * (tid >> 5);
    f32x4 sA = {0.f, 0.f, 0.f, 0.f}, sB = {0.f, 0.f, 0.f, 0.f};
    for (int i = 1; i <= wdw; ++i) { const int t = t0 - i; if (t >= 0) { f32x4 a, b; unpack8(*(const u32x4*)(up + (size_t)t * D + col), a, b); sA += a; sB += b; } }
#pragma unroll 4
    for (int tt = 0; tt < 16; ++tt) {
        const int t = t0 + tt;
        f32x4 ca, cb; unpack8(*(const u32x4*)(up + (size_t)t * D + col), ca, cb);
        sA += ca; sB += cb;
        if (t - wdw >= 0) { f32x4 a, b; unpack8(*(const u32x4*)(up + (size_t)(t - wdw) * D + col), a, b); sA -= a; sB -= b; }
        const float rc = 1.0f / (float)((t + 1 < wdw) ? (t + 1) : wdw);
        *(u32x4*)(pooled + (size_t)t * D + col) = pack8(sA * rc - ca, sB * rc - cb);
    }
}

__device__ __forceinline__ void fill_rstd(LAS float* xl, const float* ssq, const pg8::StaticOrder& S, int tid) {
    if (tid < 256) {
#pragma unroll
        for (int i = 0; i < 6; ++i) { pg8::Unit u; if (S.next(i, u)) { const int r = u.pm * 256 + tid;
            xl[XL_BYTES / 4 + i * 256 + tid] = __builtin_amdgcn_rsqf(((ssq[r] + ssq[M + r]) + (ssq[2 * M + r] + ssq[3 * M + r])) * (1.0f / 1024.0f) + NORM_EPS); } }
    }
    __syncthreads();
}
typedef const __attribute__((address_space(4))) Args* KArgsPtr;
#define KARGS(ap) KArgsPtr ap = (KArgsPtr)__builtin_amdgcn_kernarg_segment_ptr(); asm volatile("" : "+s"(ap))

__global__ void __launch_bounds__(NTHREADS, 2) fwd_megakernel(Args args_unused) {
    extern __shared__ __attribute__((aligned(16))) unsigned char lds_raw[];
    cg::grid_group grid = cg::this_grid();
    LAS unsigned char* lds = (LAS unsigned char*)lds_raw;
    LAS float* xl = (LAS float*)(lds + XL_OFF);
    const int wv = __builtin_amdgcn_readfirstlane(threadIdx.x >> 6);
    volatile LAS unsigned* bst = (volatile LAS unsigned*)(lds + LDS_BYTES - 16);
    if (wv == 0) { if (lane_id() == 0) { bst[0] = 0u; bst[1] = 0u; KARGS(ap0); (void)xb_add((unsigned*)(ap0->ws + WS_BAR) + XB_XCNT(xb_xcc_id()), 1u); } }
    __syncthreads();
#define GRID_BAR() do { KARGS(apb); grid_barrier((unsigned*)(apb->ws + WS_BAR), bst, wv); } while (0)
    if (gridDim.x == 0x7fffffffu) grid.sync();

    {
        KARGS(ap);
        unsigned char* ws = ap->ws;
        const int bx = blockIdx.x, G = gridDim.x, vcu = (bx % 8) * (G / 8) + bx / 8;
        int tid = (wv << 6) | lane_id(); asm volatile("" : "+v"(tid));
        const int lane = tid & 63, wave = wv;
        LAS float* scr = (LAS float*)(lds + wave * 16384);
        const int gw = vcu * NWAVES + wave, NGW = G * NWAVES;
        constexpr int I_IN = 16 * 192, I_OUT = 16 * 32, I_FF = 16 * 176, I_FO = 44 * 32, I_PL = 128, I_LAYER = I_IN + I_OUT + I_FF + I_FO + I_PL;
        for (int it = gw; it < DEPTH * I_LAYER; it += NGW) {
            const int L = it / I_LAYER; int r = it % I_LAYER;
            unsigned char* wl = ws + WS_W + (size_t)L * LAYER_W;
            if (r < I_IN) { const int kb = r / 192, nb = r % 192;
                p0_transpose_item(ap->in[2] + (size_t)L * D * NIN, D, NIN, (bf16_t*)(wl + OFF_WIN), 32 * nb, ap->in[1] + L * D, scr, 64 * kb, 32 * nb, lane); continue; }
            r -= I_IN;
            if (r < I_OUT) { const int kb = r / 32, nb = r % 32;
                p0_transpose_item(ap->in[12] + (size_t)L * D * D, D, D, (bf16_t*)(wl + OFF_WOUT), 32 * nb, nullptr, scr, 64 * kb, 32 * nb, lane); continue; }
            r -= I_OUT;
            if (r < I_FF) { const int kb = r / 176, nb = r % 176; const int n0 = 32 * nb, up = (n0 >= FF) ? 1 : 0, j = n0 - up * FF;
                p0_transpose_item(ap->in[14] + (size_t)L * D * NFF2, D, NFF2, (bf16_t*)(wl + OFF_WFF), 256 * (j / 128) + 128 * up + (j % 128), ap->in[13] + L * D, scr, 64 * kb, n0, lane); continue; }
            r -= I_FF;
            if (r < I_FO) { const int kb = r / 32, nb = r % 32;
                p0_transpose_item(ap->in[15] + (size_t)L * FF * D, FF, D, (bf16_t*)(wl + OFF_WFO), 32 * nb, nullptr, scr, 64 * kb, 32 * nb, lane); continue; }
            r -= I_FO;
            { const int gg = r / 32, rr = r % 32, kb = rr / 8, nb = rr % 8;
                p0_transpose_item(ap->in[10] + (size_t)L * 4 * 65536 + (size_t)gg * 65536, 256, 256, (bf16_t*)(wl + OFF_POOL) + (size_t)gg * 65536, 32 * nb, nullptr, scr, 64 * kb, 32 * nb, lane); }
        }
        const float* x_in = ap->in[0];
        bf16_t* xb = (bf16_t*)(ws + WS_XB); float* ssq = (float*)(ws + WS_SSQ);
        for (int m = gw; m < M; m += NGW) {
            const f32x4* xr = (const f32x4*)(x_in + (size_t)m * D) + lane;
            float s = 0.f;
#pragma unroll
            for (int j = 0; j < 4; ++j) { const f32x4 v = xr[64 * j]; s += (v[0] * v[0] + v[1] * v[1]) + (v[2] * v[2] + v[3] * v[3]);
                u32x2 w2; w2.x = cvt_pk_bf16(v[0], v[1]); w2.y = cvt_pk_bf16(v[2], v[3]); *((u32x2*)(xb + (size_t)m * D) + lane + 64 * j) = w2; }
            s = wave_sum(s);
            if (lane < 4) ssq[(size_t)lane * M + m] = (lane == 0) ? s : 0.f;
        }
        float* rcos = (float*)(ws + WS_COS); float* rsin = (float*)(ws + WS_SIN);
        for (int idx = vcu * NTHREADS + tid; idx < M * 16; idx += G * NTHREADS) {
            const int pos = idx >> 4, j = idx & 15;
            const float ang = (float)pos * ap->invf[j];
            float sn, cs; sincos_d(ang, sn, cs);
            rcos[idx] = cs; rsin[idx] = sn;
        }
    }
    GRID_BAR();

#pragma unroll 1
    for (int L = 0; L < DEPTH; ++L) {
        {
            KARGS(ap); unsigned char* ws = ap->ws; unsigned char* wl = ws + WS_W + (size_t)L * LAYER_W;
            pg8::Gemm g{(const bf16_t*)(ws + WS_XB), (const bf16_t*)(wl + OFF_WIN), D, D, D, 0};
            int bxl = blockIdx.x; asm volatile("" : "+s"(bxl)); pg8::StaticOrder S; S.init(M, NIN, GRID, bxl);
            pg8::EpiIn E{ws, ap->in[3] + L * 128, ap->in[4] + L * 128, xl};
            fill_rstd(xl, (const float*)(ws + WS_SSQ), S, (wv << 6) | lane_id());
            pg8::gemm_phase<pg8::EpiIn, true>(lds, g, S, E, wv);
        }
        GRID_BAR();
        {
            KARGS(ap); unsigned char* ws = ap->ws;
            int ln = lane_id(); asm volatile("" : "+v"(ln));
            const float lam_init = 0.8f - 0.6f * expf(-0.3f * (float)L);
            const float* lq1 = ap->in[5] + L * 128; const float* lk1 = ap->in[6] + L * 128; const float* lq2 = ap->in[7] + L * 128; const float* lk2 = ap->in[8] + L * 128;
            const float d1 = wave_sum_rl(lq1[ln] * lk1[ln] + lq1[ln + 64] * lk1[ln + 64]);
            const float d2 = wave_sum_rl(lq2[ln] * lk2[ln] + lq2[ln + 64] * lk2[ln + 64]);
            const float lam = expf(d1) - expf(d2) + lam_init;
            const float* gq = ap->in[3] + L * 128; const float* gk = ap->in[4] + L * 128;
            const float mq = wave_max_rl(fmaxf(fabsf(gq[ln]), fabsf(gq[ln + 64]))), mk = wave_max_rl(fmaxf(fabsf(gk[ln]), fabsf(gk[ln + 64])));
            const float cshift = 11.313708498984761f * 1.4426950408889634f * mq * mk;
            int bx = blockIdx.x; asm volatile("" : "+s"(bx)); const int vcu = (bx % 8) * (GRID / 8) + bx / 8;
            const int hc = vcu >> 5, p = vcu & 31, h = hc >> 1, comp = hc & 1;
            const bf16_t* act0 = (const bf16_t*)(ws + WS_ACT);
            const bf16_t* Qb = act0 + ACT_ELEMS; const bf16_t* Kb = act0 + 2 * ACT_ELEMS; const bf16_t* Vb = act0 + 3 * ACT_ELEMS;
            bf16_t* Oc = (bf16_t*)(ws + (comp ? WS_XB : WS_ATTN));
            const float oscale = comp ? lam : 1.0f;
            if (cshift <= 64.0f) {
                if (wv >= 4) { att::attn_item2<false, true>(h, comp, 63 - p, Qb, Kb, Vb, Oc, (char*)lds_raw, oscale, 0.0f, wv); att::attn_item2<false, true>(h, comp, p, Qb, Kb, Vb, Oc, (char*)lds_raw, oscale, 0.0f, wv); }
                else         { att::attn_item2<false, false>(h, comp, 63 - p, Qb, Kb, Vb, Oc, (char*)lds_raw, oscale, 0.0f, wv); att::attn_item2<false, false>(h, comp, p, Qb, Kb, Vb, Oc, (char*)lds_raw, oscale, 0.0f, wv); }
            } else {
                if (wv >= 4) { att::attn_item2<true, true>(h, comp, 63 - p, Qb, Kb, Vb, Oc, (char*)lds_raw, oscale, cshift, wv); att::attn_item2<true, true>(h, comp, p, Qb, Kb, Vb, Oc, (char*)lds_raw, oscale, cshift, wv); }
                else         { att::attn_item2<true, false>(h, comp, 63 - p, Qb, Kb, Vb, Oc, (char*)lds_raw, oscale, cshift, wv); att::attn_item2<true, false>(h, comp, p, Qb, Kb, Vb, Oc, (char*)lds_raw, oscale, cshift, wv); }
            }
        }
        GRID_BAR();
        {
            KARGS(ap); unsigned char* ws = ap->ws; unsigned char* wl = ws + WS_W + (size_t)L * LAYER_W;
            bf16_t* act0 = (bf16_t*)(ws + WS_ACT);
            int bxl = blockIdx.x; asm volatile("" : "+s"(bxl)); pg8::StaticOrder S; S.init(M, D, GRID, bxl);
            pg8::Unit u;
            (void)S.next(0, u); pooled_tile(act0, (bf16_t*)(ws + WS_POOLED), u.pm, u.pn, (wv << 6) | lane_id());
            asm volatile("s_waitcnt vmcnt(0)" ::: "memory");
            __syncthreads();
            pg8::Gemm g{(const bf16_t*)(ws + WS_POOLED), (const bf16_t*)(wl + OFF_POOL), D, 256, 256, 256};
            pg8::EpiMerge E{act0 + 4 * ACT_ELEMS, act0 + 5 * ACT_ELEMS, (const bf16_t*)(ws + WS_ATTN), (const bf16_t*)(ws + WS_XB), ap->in[11] + L * D, ap->in[9] + L * 256, (bf16_t*)(ws + WS_MERGED),
                            1.0f - (0.8f - 0.6f * expf(-0.3f * (float)L)), xl};
            pg8::gemm_phase<pg8::EpiMerge, false>(lds, g, S, E, wv);
        }
        GRID_BAR();
        {
            KARGS(ap); unsigned char* ws = ap->ws; unsigned char* wl = ws + WS_W + (size_t)L * LAYER_W;
            pg8::Gemm g{(const bf16_t*)(ws + WS_MERGED), (const bf16_t*)(wl + OFF_WOUT), D, D, D, 0};
            int bxl = blockIdx.x; asm volatile("" : "+s"(bxl)); pg8::StaticOrder S; S.init(M, D, GRID, bxl);
            pg8::EpiRes E{(L == 0) ? ap->in[0] : (const float*)ap->out, ap->out, (bf16_t*)(ws + WS_XB), (float*)(ws + WS_SSQ), lds};
            pg8::gemm_phase<pg8::EpiRes, false>(lds, g, S, E, wv);
        }
        GRID_BAR();
        {
            KARGS(ap); unsigned char* ws = ap->ws; unsigned char* wl = ws + WS_W + (size_t)L * LAYER_W;
            pg8::Gemm g{(const bf16_t*)(ws + WS_XB), (const bf16_t*)(wl + OFF_WFF), D, D, D, 0};
            int bxl = blockIdx.x; asm volatile("" : "+s"(bxl)); pg8::StaticOrder S; S.init(M, NFF2, GRID, bxl);
            pg8::EpiSwiGLU E{(bf16_t*)(ws + WS_FFACT), xl};
            fill_rstd(xl, (const float*)(ws + WS_SSQ), S, (wv << 6) | lane_id());
            pg8::gemm_phase<pg8::EpiSwiGLU, true>(lds, g, S, E, wv);
        }
        GRID_BAR();
        {
            KARGS(ap); unsigned char* ws = ap->ws; unsigned char* wl = ws + WS_W + (size_t)L * LAYER_W;
            pg8::Gemm g{(const bf16_t*)(ws + WS_FFACT), (const bf16_t*)(wl + OFF_WFO), FF, FF, FF, 0};
            int bxl = blockIdx.x; asm volatile("" : "+s"(bxl)); pg8::StaticOrder S; S.init(M, D, GRID, bxl);
            pg8::EpiRes E{(const float*)ap->out, ap->out, (bf16_t*)(ws + WS_XB), (float*)(ws + WS_SSQ), lds};
            pg8::gemm_phase<pg8::EpiRes, false>(lds, g, S, E, wv);
        }
        if (L + 1 < DEPTH) GRID_BAR();
    }
}

extern "C" void kernel_launch(void* const* d_in, const int* in_sizes, int n_in, void* d_out, int out_size, void* d_ws, size_t ws_size, hipStream_t stream) {
    static int ready = 0;
    if (ready == 0) {
        if (n_in != 16 || in_sizes[0] != M * D || out_size != M * D || ws_size < WS_END) {
            fprintf(stderr, "kernel_launch: unexpected shapes (n_in %d, in0 %d, out %d, ws %zu < %zu); nothing launched\n", n_in, n_in > 0 ? in_sizes[0] : -1, out_size, ws_size, (size_t)WS_END); ready = -1; return; }
        if (hipFuncSetAttribute((const void*)fwd_megakernel, hipFuncAttributeMaxDynamicSharedMemorySize, LDS_BYTES) != hipSuccess) { fprintf(stderr, "kernel_launch: hipFuncSetAttribute failed\n"); ready = -1; return; }
        int dev = 0, cus = 0, per_cu = 0;
        (void)hipGetDevice(&dev); (void)hipDeviceGetAttribute(&cus, hipDeviceAttributeMultiprocessorCount, dev);
        (void)hipOccupancyMaxActiveBlocksPerMultiprocessor(&per_cu, (const void*)fwd_megakernel, NTHREADS, LDS_BYTES);
        if (cus * per_cu < GRID) fprintf(stderr, "kernel_launch: note: %d CUs x %d blocks/CU < grid %d\n", cus, per_cu, GRID);
        (void)hipGetLastError();
        ready = 1;
    }
    if (ready < 0) return;
    if (hipMemsetAsync((char*)d_ws + WS_BAR, 0, WS_BAR_BYTES, stream) != hipSuccess) { fprintf(stderr, "kernel_launch: hipMemsetAsync failed\n"); return; }
    Args a{};
    for (int i = 0; i < 16; ++i) a.in[i] = (const float*)d_in[i];
    a.out = (float*)d_out; a.ws = (unsigned char*)d_ws;
    for (int j = 0; j < 16; ++j) a.invf[j] = (float)pow(500000.0, -(double)j / 16.0);
    void* kargs[] = {&a};
    hipError_t e = hipLaunchCooperativeKernel((const void*)fwd_megakernel, dim3(GRID), dim3(NTHREADS), kargs, LDS_BYTES, stream);
    if (e != hipSuccess) fprintf(stderr, "kernel_launch: cooperative launch failed: %s\n", hipGetErrorString(e));
}
```

```cpp
#include <hip/hip_runtime.h>
#include <hip/hip_cooperative_groups.h>
#include <cstdio>
#include <cstdint>
#include <cmath>
namespace cg = cooperative_groups;

#define LAS __attribute__((address_space(3)))
typedef unsigned short bf16_t;
typedef short bf16x8 __attribute__((ext_vector_type(8)));
typedef float f32x4 __attribute__((ext_vector_type(4)));
typedef float f32x16 __attribute__((ext_vector_type(16)));
typedef unsigned u32x4 __attribute__((ext_vector_type(4)));
typedef unsigned u32x2 __attribute__((ext_vector_type(2)));

constexpr int M = 16384, D = 1024, NIN = 6144, FF = 2816, NFF2 = 5632, DEPTH = 4;
constexpr float NORM_EPS = 1e-6f;
constexpr float QSC = 0.08838834764831845f * 1.4426950408889634f;
constexpr size_t ACT_ELEMS = (size_t)M * D;

constexpr size_t MiB = 1u << 20;
constexpr size_t SZ_WIN = (size_t)NIN * D * 2, SZ_WOUT = (size_t)D * D * 2, SZ_WFF = (size_t)NFF2 * D * 2, SZ_WFO = (size_t)D * FF * 2, SZ_POOL = 4 * 256 * 256 * 2;
constexpr size_t OFF_WIN = 0, OFF_WOUT = OFF_WIN + SZ_WIN, OFF_WFF = OFF_WOUT + SZ_WOUT, OFF_WFO = OFF_WFF + SZ_WFF, OFF_POOL = OFF_WFO + SZ_WFO, LAYER_W = OFF_POOL + SZ_POOL;
static_assert(LAYER_W == 31 * MiB, "weights per layer");
constexpr size_t WS_W = 0;
constexpr size_t WS_ACT = 124 * MiB;
constexpr size_t WS_ATTN = WS_ACT + 6 * 32 * MiB;
constexpr size_t WS_XB = WS_ATTN + 32 * MiB;
constexpr size_t WS_SSQ = WS_XB + 32 * MiB;
constexpr size_t WS_COS = WS_SSQ + 4 * M * 4;
constexpr size_t WS_SIN = WS_COS + (size_t)M * 16 * 4;
constexpr size_t WS_BAR = WS_SIN + (size_t)M * 16 * 4;
constexpr size_t WS_BAR_BYTES = 16384;
constexpr size_t WS_END = WS_BAR + WS_BAR_BYTES;
constexpr size_t WS_FFACT = WS_ACT;
constexpr size_t WS_MERGED = WS_ACT + 32 * MiB;
constexpr size_t WS_POOLED = WS_ACT + 64 * MiB;
static_assert((size_t)M * FF * 2 <= 96 * MiB, "ffn activation overlay");

constexpr int RING_BYTES = 131072, XL_OFF = RING_BYTES, XL_BYTES = 8192, LDS_BYTES = 163840;
constexpr int NWAVES = 8, NTHREADS = 512, GRID = 256;

__device__ __forceinline__ unsigned cvt_pk_bf16(float lo, float hi) { unsigned r; asm volatile("v_cvt_pk_bf16_f32 %0, %1, %2" : "=v"(r) : "v"(lo), "v"(hi)); return r; }
__device__ __forceinline__ float bf_lo(unsigned w) { return __uint_as_float(w << 16); }
__device__ __forceinline__ float bf_hi(unsigned w) { return __uint_as_float(w & 0xffff0000u); }
__device__ __forceinline__ u32x4 pack8(const f32x4 a, const f32x4 b) { u32x4 w; w.x = cvt_pk_bf16(a[0], a[1]); w.y = cvt_pk_bf16(a[2], a[3]); w.z = cvt_pk_bf16(b[0], b[1]); w.w = cvt_pk_bf16(b[2], b[3]); return w; }
__device__ __forceinline__ void unpack8(const u32x4 w, f32x4& a, f32x4& b) { a = (f32x4){bf_lo(w.x), bf_hi(w.x), bf_lo(w.y), bf_hi(w.y)}; b = (f32x4){bf_lo(w.z), bf_hi(w.z), bf_lo(w.w), bf_hi(w.w)}; }
__device__ __forceinline__ float sigmoidf_(float x) { return __builtin_amdgcn_rcpf(1.0f + __builtin_amdgcn_exp2f(-1.4426950408889634f * x)); }
__device__ __forceinline__ int lane_id() { int r; asm volatile("v_mbcnt_lo_u32_b32 %0, -1, 0\n\tv_mbcnt_hi_u32_b32 %0, -1, %0" : "=v"(r)); return r; }
#define XB_TMO      128
#define XB_XCNT(j)  (256  + 64 * (j))
#define XB_XSUB(j)  (1280 + 64 * (j))
#define XB_XGEN(j)  (2304 + 64 * (j))
#define XB_TOP      3328
#define XB_TOPGEN   3392
#define XCD_BAR_WORDS 3456
#define XB_SPIN_CAP (1u << 22)
__device__ __forceinline__ unsigned xb_ld(unsigned* p)              { return __hip_atomic_load(p, __ATOMIC_RELAXED, __HIP_MEMORY_SCOPE_AGENT); }
__device__ __forceinline__ unsigned xb_add(unsigned* p, unsigned v) { return __hip_atomic_fetch_add(p, v, __ATOMIC_RELAXED, __HIP_MEMORY_SCOPE_AGENT); }
__device__ __forceinline__ unsigned xb_xcc_id() { return (unsigned)__builtin_amdgcn_s_getreg((3 << 11) | 20) & 0xFu; }
#define XB_SPIN(cond, bar) do { unsigned _sp = 0; while (cond) { __builtin_amdgcn_s_sleep(1); \
    if ((++_sp & 255u) == 0u) { if (xb_ld(&(bar)[XB_TMO])) break; if (_sp > XB_SPIN_CAP) { atomicAdd(&(bar)[XB_TMO], 1u); break; } } } } while (0)
__device__ __forceinline__ void xcd_barrier_complete(unsigned* bar, unsigned x, unsigned& nloc, unsigned& nx) {
    const unsigned G = gridDim.x;
    unsigned sum, cnt, mine, sp = 0u;
    for (;;) {
        sum = 0u; cnt = 0u; mine = 0u;
#pragma unroll
        for (unsigned j = 0; j < 16; ++j) { const unsigned c = xb_ld(&bar[XB_XCNT(j)]); sum += c; cnt += (c > 0u) ? 1u : 0u; mine = (j == x) ? c : mine; }
        if (sum == G) break;
        __builtin_amdgcn_s_sleep(1);
        if ((++sp & 255u) == 0u) { if (xb_ld(&bar[XB_TMO])) break; if (sp > XB_SPIN_CAP) { atomicAdd(&bar[XB_TMO], 1u); break; } }
    }
    nloc = mine > 0u ? mine : 1u; nx = cnt > 0u ? cnt : 1u;
}
__device__ __forceinline__ void grid_barrier(unsigned* bar, volatile LAS unsigned* st, int wv) {
    asm volatile("s_waitcnt vmcnt(0) lgkmcnt(0)" ::: "memory");
    __syncthreads();
    if (wv == 0) {
        if (lane_id() == 0) {
            const unsigned x = xb_xcc_id();
            unsigned nloc = st[0], nx = st[1];
            if (nloc == 0u) { xcd_barrier_complete(bar, x, nloc, nx); st[0] = nloc; st[1] = nx; }
            const unsigned old = xb_add(&bar[XB_XSUB(x)], 1u);
            const unsigned gen = old / nloc;
            if (old + 1u == (gen + 1u) * nloc) {
                __builtin_amdgcn_fence(__ATOMIC_RELEASE, "agent");
                asm volatile("s_waitcnt vmcnt(0)" ::: "memory");
                const unsigned og = xb_add(&bar[XB_TOP], 1u);
                const unsigned tg = og / nx;
                if (og + 1u == (tg + 1u) * nx) xb_add(&bar[XB_TOPGEN], 1u);
                else XB_SPIN(xb_ld(&bar[XB_TOPGEN]) == tg, bar);
                __builtin_amdgcn_fence(__ATOMIC_ACQUIRE, "agent");
                xb_add(&bar[XB_XGEN(x)], 1u);
                asm volatile("s_waitcnt vmcnt(0)" ::: "memory");
            } else {
                XB_SPIN(xb_ld(&bar[XB_XGEN(x)]) == gen, bar);
                __builtin_amdgcn_fence(__ATOMIC_ACQUIRE, "agent");
                asm volatile("s_waitcnt vmcnt(0)" ::: "memory");
            }
        }
    }
    __syncthreads();
}
__device__ __forceinline__ float xor32_sum(float v) { auto rr = __builtin_amdgcn_permlane32_swap(__float_as_uint(v), __float_as_uint(v), false, false); return __uint_as_float(rr[0]) + __uint_as_float(rr[1]); }
__device__ __forceinline__ float xor32_get(float v, int hi) { auto rr = __builtin_amdgcn_permlane32_swap(__float_as_uint(v), __float_as_uint(v), false, false); return hi ? __uint_as_float(rr[0]) : __uint_as_float(rr[1]); }
__device__ __forceinline__ float xor16_sum(float v) { return v + __uint_as_float((unsigned)__builtin_amdgcn_ds_swizzle((int)__float_as_uint(v), 0x401F)); }
__device__ __forceinline__ float wave_sum_rl(float v) { float s = 0.f;
#pragma unroll
    for (int i = 0; i < 64; ++i) s += __uint_as_float((unsigned)__builtin_amdgcn_readlane((int)__float_as_uint(v), i));
    return s; }
__device__ __forceinline__ float wave_max_rl(float v) { float s = 0.f;
#pragma unroll
    for (int i = 0; i < 64; ++i) s = fmaxf(s, __uint_as_float((unsigned)__builtin_amdgcn_readlane((int)__float_as_uint(v), i)));
    return s; }
#define LDS_BAR() do { asm volatile("s_waitcnt lgkmcnt(0)" ::: "memory"); __builtin_amdgcn_s_barrier(); asm volatile("" ::: "memory"); } while (0)

namespace pg8 {
constexpr int BM = 256, BK = 64, HALF = 128, HTB = HALF * BK * 2, NXCD = 8, WGM = 8;
__device__ __forceinline__ int lds_byte(int r, int c) { const int st = (r >> 4) * 2 + (c >> 5), rr = r & 15, cc = c & 31, ob = rr * 64 + cc * 2; return st * 1024 + (ob ^ (((ob >> 9) & 1) << 5)); }
__device__ __forceinline__ void stage_rc(int b, int& R, int& C) { const int st = b / 1024, sb = b % 1024, swz = sb ^ (((sb >> 9) & 1) << 5); R = (st >> 1) * 16 + swz / 64; C = (st & 1) * 32 + (swz % 64) / 2; }
__device__ __forceinline__ int perm32(int rho) { const int n = rho >> 4, i = rho & 15; return 8 * (i >> 2) + 4 * n + (i & 3); }

struct Unit { int pm, pn; };
struct Gemm { const bf16_t* A; const bf16_t* Bt; int lda, ldb, K, a_cpn; };

struct StaticOrder {
    int nM, nN, nwg, G, c;
    __device__ void init(int M_, int N_, int G_, int c_) { nM = M_ / BM; nN = N_ / BM; nwg = nM * nN; G = G_; c = c_; }
    __device__ bool next(int i, Unit& u) const {
        const long L = (long)i * G + c; if (L >= nwg) return false;
        int wgid = (int)L; { const int q = nwg / NXCD, r = nwg % NXCD, xcd = wgid % NXCD, off = wgid / NXCD; wgid = (xcd < r ? xcd * (q + 1) : r * (q + 1) + (xcd - r) * q) + off; }
        const int nig = WGM * nN, gid = wgid / nig, fm = gid * WGM, gsz = (nM - fm) < WGM ? (nM - fm) : WGM;
        u.pm = fm + ((wgid % nig) % gsz); u.pn = (wgid % nig) / gsz; return true;
    }
};


struct EpiIn {
    static constexpr bool PERM = true, AFTER_DRAIN = false;
    unsigned char* ws; const float* gq; const float* gk; LAS float* xl;
    __device__ __forceinline__ void operator()(f32x4 (&acc)[2][2][4][2], const Unit& u, int wr, int wc, int fr, int fq, int wid, int lane, int ui) const {
        bf16_t* out0 = (bf16_t*)(ws + WS_ACT); const float* rcos = (const float*)(ws + WS_COS); const float* rsin = (const float*)(ws + WS_SIN);
        const LAS float* rsl = xl + XL_BYTES / 4 + ui * 256;
        const int kind = u.pn >> 2, cb = (u.pn & 3) * 256;
        bf16_t* dst = out0 + (size_t)kind * ACT_ELEMS;
        const int row0 = u.pm * BM + wr * 64 + fr, colw = wc * 32 + 8 * fq;
#pragma unroll
        for (int ai = 0; ai < 2; ++ai)
#pragma unroll
            for (int m = 0; m < 4; ++m) {
                const float rs = rsl[ai * HALF + wr * 64 + m * 16 + fr];
#pragma unroll
                for (int bj = 0; bj < 2; ++bj)
#pragma unroll
                    for (int n = 0; n < 2; ++n) acc[ai][bj][m][n] *= rs;
                if (m & 1) __builtin_amdgcn_sched_barrier(0);
            }
        if (kind == 1 || kind == 2) {
            const float* g = (kind == 1) ? gq : gk;
#pragma unroll
            for (int ai = 0; ai < 2; ++ai)
#pragma unroll
                for (int m = 0; m < 4; ++m)
#pragma unroll
                    for (int bj = 0; bj < 2; ++bj) {
                        const f32x4 a = acc[ai][bj][m][0], b = acc[ai][bj][m][1];
                        float ss = (a[0] * a[0] + a[1] * a[1]) + (a[2] * a[2] + a[3] * a[3]) + (b[0] * b[0] + b[1] * b[1]) + (b[2] * b[2] + b[3] * b[3]);
                        ss = xor32_sum(xor16_sum(ss));
                        if (fq == 0) xl[((ai * HALF + wr * 64 + m * 16 + fr) * 2 + bj) * 4 + wc] = ss;
                    }
            LDS_BAR();
            const f32x4 g0 = *(const f32x4*)(g + colw), g1 = *(const f32x4*)(g + colw + 4);
            const float osc = (kind == 1) ? QSC : 1.0f, a8 = (kind == 1) ? 256.0f : 32.0f;
            const float sgn = (fq < 2) ? -1.0f : 1.0f;
#pragma unroll
            for (int ai = 0; ai < 2; ++ai)
#pragma unroll
                for (int m = 0; m < 4; ++m) {
                    const int rt = ai * HALF + wr * 64 + m * 16 + fr, r = u.pm * BM + rt;
                    f32x4 c0, c1, s0, s1;
                    if (wc == 0) { const int j0 = 8 * (fq & 1); c0 = *(const f32x4*)(rcos + (size_t)r * 16 + j0); c1 = *(const f32x4*)(rcos + (size_t)r * 16 + j0 + 4);
                                   s0 = *(const f32x4*)(rsin + (size_t)r * 16 + j0); s1 = *(const f32x4*)(rsin + (size_t)r * 16 + j0 + 4); }
#pragma unroll
                    for (int bj = 0; bj < 2; ++bj) {
                        const f32x4 t4 = *(const LAS f32x4*)(xl + (rt * 2 + bj) * 4);
                        const float rn = __builtin_amdgcn_rsqf(((t4[0] + t4[1]) + (t4[2] + t4[3])) * (1.0f / 128.0f) + NORM_EPS);
                        f32x4 v0 = acc[ai][bj][m][0] * rn * g0, v1 = acc[ai][bj][m][1] * rn * g1;
                        if (wc == 0) {
                            f32x4 p0, p1;
#pragma unroll
                            for (int i = 0; i < 4; ++i) { p0[i] = xor32_get(v0[i], fq >> 1); p1[i] = xor32_get(v1[i], fq >> 1); }
                            v0 = v0 * c0 + (p0 * s0) * sgn; v1 = v1 * c1 + (p1 * s1) * sgn;
                        }
                        v0 *= osc; v1 *= osc;
                        unsigned wq[2];
#pragma unroll
                        for (int hh = 0; hh < 2; ++hh) { const f32x4 vv = hh ? v1 : v0; unsigned w = 0;
#pragma unroll
                            for (int i = 0; i < 4; ++i) { const int iv = (int)__builtin_rintf(fminf(fmaxf(vv[i] * a8, -127.0f), 127.0f)); w |= ((unsigned)iv & 255u) << (8 * i); }
                            wq[hh] = w; }
                        *(u32x2*)((unsigned char*)dst + (size_t)r * D + cb + bj * HALF + colw) = (u32x2){wq[0], wq[1]};
                    }
                    __builtin_amdgcn_sched_barrier(0);
                }
        } else {
            const bool sg = kind >= 4;
#pragma unroll
            for (int ai = 0; ai < 2; ++ai)
#pragma unroll
                for (int m = 0; m < 4; ++m) {
                    const int r = row0 + ai * HALF + m * 16;
#pragma unroll
                    for (int bj = 0; bj < 2; ++bj) {
                        f32x4 v0 = acc[ai][bj][m][0], v1 = acc[ai][bj][m][1];
                        if (sg) {
#pragma unroll
                            for (int i = 0; i < 4; ++i) { v0[i] = sigmoidf_(v0[i]); v1[i] = sigmoidf_(v1[i]); }
                        }
                        *(u32x4*)(dst + (size_t)r * D + cb + bj * HALF + colw) = pack8(v0, v1);
                    }
                }
        }
    }
};

struct EpiSwiGLU {
    static constexpr bool PERM = true, AFTER_DRAIN = false;
    bf16_t* act; LAS float* xl;
    __device__ __forceinline__ void operator()(f32x4 (&acc)[2][2][4][2], const Unit& u, int wr, int wc, int fr, int fq, int wid, int lane, int ui) const {
        const int row0 = u.pm * BM + wr * 64 + fr, col = u.pn * HALF + wc * 32 + 8 * fq;
#pragma unroll
        for (int ai = 0; ai < 2; ++ai)
#pragma unroll
            for (int m = 0; m < 4; ++m) {
                const int r = row0 + ai * HALF + m * 16;
                const float rs = xl[XL_BYTES / 4 + ui * 256 + ai * HALF + wr * 64 + m * 16 + fr];
                f32x4 o[2];
#pragma unroll
                for (int n = 0; n < 2; ++n) {
                    const f32x4 gt = acc[ai][0][m][n] * rs, up = acc[ai][1][m][n] * rs;
#pragma unroll
                    for (int i = 0; i < 4; ++i) o[n][i] = gt[i] * sigmoidf_(gt[i]) * up[i];
                }
                *(u32x4*)(act + (size_t)r * FF + col) = pack8(o[0], o[1]);
            }
    }
};

struct EpiMerge {
    static constexpr bool PERM = true, AFTER_DRAIN = true;
    const bf16_t* sga; const bf16_t* sgb; const bf16_t* o0; const bf16_t* o1; const float* pscale; const float* subg; bf16_t* merged; float osc; LAS float* xl;
    __device__ __forceinline__ void operator()(f32x4 (&acc)[2][2][4][2], const Unit& u, int wr, int wc, int fr, int fq, int wid, int lane, int ui) const {
        const int row0 = u.pm * BM + wr * 64 + fr;
#pragma unroll
        for (int ai = 0; ai < 2; ++ai)
#pragma unroll
            for (int m = 0; m < 4; ++m) {
                float ss = 0.f;
#pragma unroll
                for (int bj = 0; bj < 2; ++bj) {
                    const size_t off = (size_t)(row0 + ai * HALF + m * 16) * D + u.pn * BM + bj * HALF + wc * 32 + 8 * fq;
                    f32x4 a0, a1, b0, b1; unpack8(*(const u32x4*)(o0 + off), a0, a1); unpack8(*(const u32x4*)(o1 + off), b0, b1);
                    const f32x4 d0 = a0 - b0, d1 = a1 - b1;
                    ss += (d0[0] * d0[0] + d0[1] * d0[1]) + (d0[2] * d0[2] + d0[3] * d0[3]) + (d1[0] * d1[0] + d1[1] * d1[1]) + (d1[2] * d1[2] + d1[3] * d1[3]);
                }
                ss = xor32_sum(xor16_sum(ss));
                if (fq == 0) xl[(ai * HALF + wr * 64 + m * 16 + fr) * 4 + wc] = ss;
            }
        LDS_BAR();
#pragma unroll
        for (int bj = 0; bj < 2; ++bj) {
            const int col = u.pn * BM + bj * HALF + wc * 32 + 8 * fq;
            const f32x4 ps0 = *(const f32x4*)(pscale + col), ps1 = *(const f32x4*)(pscale + col + 4);
            const f32x4 g0 = *(const f32x4*)(subg + (col & 255)), g1 = *(const f32x4*)(subg + (col & 255) + 4);
#pragma unroll
            for (int ai = 0; ai < 2; ++ai)
#pragma unroll
                for (int m = 0; m < 4; ++m) {
                    const int rt = ai * HALF + wr * 64 + m * 16 + fr;
                    const f32x4 t4 = *(const LAS f32x4*)(xl + rt * 4);
                    const float rn = __builtin_amdgcn_rsqf(((t4[0] + t4[1]) + (t4[2] + t4[3])) * (1.0f / 256.0f) + NORM_EPS) * osc;
                    const size_t off = (size_t)(u.pm * BM + rt) * D + col;
                    const u32x4 wa = *(const u32x4*)(sga + off), wb = *(const u32x4*)(sgb + off), w0 = *(const u32x4*)(o0 + off), w1 = *(const u32x4*)(o1 + off);
                    f32x4 a0, a1, b0, b1, x0, x1, y0, y1; unpack8(wa, a0, a1); unpack8(wb, b0, b1); unpack8(w0, x0, x1); unpack8(w1, y0, y1);
                    const f32x4 t0 = (x0 - y0) * g0 * rn, t1 = (x1 - y1) * g1 * rn;
                    const f32x4 r0 = a0 * (acc[ai][bj][m][0] * ps0) + b0 * t0, r1 = a1 * (acc[ai][bj][m][1] * ps1) + b1 * t1;
                    *(u32x4*)(merged + off) = pack8(r0, r1);
                }
        }
        LDS_BAR();
    }
};

__device__ __forceinline__ float swz_sum32(float v) {
    v += __uint_as_float((unsigned)__builtin_amdgcn_ds_swizzle((int)__float_as_uint(v), 0x041F));
    v += __uint_as_float((unsigned)__builtin_amdgcn_ds_swizzle((int)__float_as_uint(v), 0x081F));
    v += __uint_as_float((unsigned)__builtin_amdgcn_ds_swizzle((int)__float_as_uint(v), 0x101F));
    v += __uint_as_float((unsigned)__builtin_amdgcn_ds_swizzle((int)__float_as_uint(v), 0x201F));
    v += __uint_as_float((unsigned)__builtin_amdgcn_ds_swizzle((int)__float_as_uint(v), 0x401F));
    return v;
}
struct EpiRes {
    static constexpr bool PERM = false, AFTER_DRAIN = true;
    const float* res; float* out; bf16_t* xb; float* ssq; LAS unsigned char* lds;
    __device__ __forceinline__ void operator()(f32x4 (&acc)[2][2][4][2], const Unit& u, int wr, int wc, int fr, int fq, int wid, int lane, int ui) const {
        constexpr int RS = 1040;
#pragma unroll
        for (int ai = 0; ai < 2; ++ai) {
#pragma unroll
            for (int m = 0; m < 4; ++m)
#pragma unroll
                for (int bj = 0; bj < 2; ++bj)
#pragma unroll
                    for (int n = 0; n < 2; ++n)
                        *(LAS f32x4*)(lds + (wr * 64 + m * 16 + fr) * RS + (bj * HALF + wc * 32 + n * 16 + 4 * fq) * 4) = acc[ai][bj][m][n];
            LDS_BAR();
#pragma unroll 1
            for (int c = 0; c < 2; ++c) {
                f32x4 rv[8];
#pragma unroll
                for (int rr = 0; rr < 8; ++rr) { const size_t grow = (size_t)(u.pm * BM + ai * HALF + wid * 16 + c * 8 + rr); rv[rr] = *((const f32x4*)(res + grow * D + u.pn * BM) + lane); }
#pragma unroll
                for (int rr = 0; rr < 8; ++rr) {
                    const int rl = wid * 16 + c * 8 + rr; const size_t grow = (size_t)(u.pm * BM + ai * HALF + rl);
                    const f32x4 v = rv[rr] + *(const LAS f32x4*)(lds + rl * RS + lane * 16);
                    *((f32x4*)(out + grow * D + u.pn * BM) + lane) = v;
                    u32x2 w; w.x = cvt_pk_bf16(v[0], v[1]); w.y = cvt_pk_bf16(v[2], v[3]);
                    *((u32x2*)(xb + grow * D + u.pn * BM) + lane) = w;
                    float ss = (v[0] * v[0] + v[1] * v[1]) + (v[2] * v[2] + v[3] * v[3]);
                    ss = xor32_sum(swz_sum32(ss));
                    if (lane == 0) ssq[(size_t)u.pn * M + grow] = ss;
                }
            }
            LDS_BAR();
        }
    }
};

template <class Epi, bool ALIGN_EPI>
__device__ __forceinline__ void gemm_phase(LAS unsigned char* lds, const Gemm g, const StaticOrder& S, const Epi& E, int wv) {
    int tid_ = (wv << 6) | lane_id(); asm volatile("" : "+v"(tid_));
    const int tid = tid_, wid = __builtin_amdgcn_readfirstlane(tid >> 6), lane = tid & 63, wr = wid >> 2, wc = wid & 3, fr = lane & 15, fq = lane >> 4;
    const int K = g.K, nt = K / BK;
    unsigned voffA[2], voffB[2];
#pragma unroll
    for (int i = 0; i < 2; ++i) { int R, C; stage_rc(tid * 16 + i * 8192, R, C); const int Rb = Epi::PERM ? ((R & ~31) + perm32(R & 31)) : R;
        voffA[i] = (unsigned)(R * g.lda + C) * 2u; voffB[i] = (unsigned)(Rb * g.ldb + C) * 2u; }
    const size_t kstep = (size_t)(BK * 2);
    const size_t hstepA = (size_t)HALF * g.lda * 2, hstepB = (size_t)HALF * g.ldb * 2;
    const unsigned ldsw = (unsigned)wid * 1024u;
    const int aoff = lds_byte(wr * 64 + fr, fq * 8), boff = lds_byte(wc * 32 + fr, fq * 8);
#define PG8_SA(b, h) (((b) * 2 + (h)) * HTB)
#define PG8_SB(b, h) ((4 + (b) * 2 + (h)) * HTB)
#define PG8_STAGE(bufoff, gbase, voff) do { _Pragma("unroll") for (int _i = 0; _i < 2; ++_i) \
        __builtin_amdgcn_global_load_lds((const unsigned*)((const char*)(gbase) + (voff)[_i]), (LAS unsigned*)(lds + (bufoff) + ldsw + _i * 8192), 16, 0, 0); } while (0)
#define PG8_LDA(dst, b, h) do { _Pragma("unroll") for (int m = 0; m < 4; ++m) _Pragma("unroll") for (int k = 0; k < 2; ++k) dst[m][k] = *(const LAS bf16x8*)(lds + PG8_SA(b, h) + aoff + m * 2048 + k * 1024); } while (0)
#define PG8_LDB(dst, b, h) do { _Pragma("unroll") for (int n = 0; n < 2; ++n) _Pragma("unroll") for (int k = 0; k < 2; ++k) dst[n][k] = *(const LAS bf16x8*)(lds + PG8_SB(b, h) + boff + n * 2048 + k * 1024); } while (0)
#define PG8_MMA(ai, bj, At, Bt) do { __builtin_amdgcn_s_setprio(1); _Pragma("unroll") for (int m = 0; m < 4; ++m) _Pragma("unroll") for (int n = 0; n < 2; ++n) _Pragma("unroll") for (int k = 0; k < 2; ++k) \
        acc[ai][bj][m][n] = __builtin_amdgcn_mfma_f32_16x16x32_bf16(Bt[n][k], At[m][k], acc[ai][bj][m][n], 0, 0, 0); __builtin_amdgcn_s_setprio(0); } while (0)
#define PG8_WAIT_V(n) asm volatile("s_waitcnt vmcnt(" #n ")" ::: "memory")
#define PG8_WAIT_L(n) asm volatile("s_waitcnt lgkmcnt(" #n ")" ::: "memory")
#define PG8_BAR __builtin_amdgcn_s_barrier()
#define PG8_SCHED __builtin_amdgcn_sched_barrier(0)
#define PG8_UA(u_) ((const char*)g.A + ((size_t)(u_).pm * BM * g.lda + (size_t)(u_).pn * g.a_cpn) * 2)
#define PG8_UB(u_) ((const char*)g.Bt + (size_t)(u_).pn * BM * g.ldb * 2)
    Unit cur, nxt; int ui = 0;
    (void)S.next(0, cur);
    f32x4 acc[2][2][4][2];
#pragma unroll
    for (int a = 0; a < 2; ++a)
#pragma unroll
        for (int b = 0; b < 2; ++b)
#pragma unroll
            for (int m = 0; m < 4; ++m)
#pragma unroll
                for (int n = 0; n < 2; ++n) acc[a][b][m][n] = (f32x4){0.f, 0.f, 0.f, 0.f};
    bf16x8 At[4][2], B0[2][2], B1[2][2];
    const char* cA = PG8_UA(cur); const char* cB = PG8_UB(cur);
    PG8_STAGE(PG8_SB(0, 0), cB, voffB); PG8_STAGE(PG8_SB(0, 1), cB + hstepB, voffB); PG8_STAGE(PG8_SA(0, 0), cA, voffA); PG8_STAGE(PG8_SA(0, 1), cA + hstepA, voffA);
    if (wr == 1) PG8_BAR;
    PG8_WAIT_V(2); PG8_BAR;
    PG8_STAGE(PG8_SB(1, 0), cB + kstep, voffB); PG8_STAGE(PG8_SA(1, 0), cA + kstep, voffA); PG8_STAGE(PG8_SB(1, 1), cB + hstepB + kstep, voffB);
    PG8_WAIT_V(6); PG8_BAR;
    for (;;) {
        const bool has_next = S.next(ui + 1, nxt);
        const char* nA = has_next ? PG8_UA(nxt) : cA; const char* nB = has_next ? PG8_UB(nxt) : cB;
        for (int t = 0; t < nt; t += 2) {
            const bool last = (t == nt - 2);
            const char* a1 = cA + (size_t)(t + 1) * kstep;
            const char* a2 = last ? nA : cA + (size_t)(t + 2) * kstep; const char* b2 = last ? nB : cB + (size_t)(t + 2) * kstep;
            const char* a3 = a2 + kstep; const char* b3 = b2 + kstep;
            PG8_LDB(B0, 0, 0); PG8_LDB(B1, 0, 1); PG8_SCHED; PG8_LDA(At, 0, 0); PG8_STAGE(PG8_SA(1, 1), a1 + hstepA, voffA);
            PG8_WAIT_V(8); PG8_WAIT_L(0); PG8_BAR; PG8_MMA(0, 0, At, B0); PG8_MMA(0, 1, At, B1); PG8_BAR; PG8_SCHED;
            PG8_LDA(At, 0, 1); PG8_STAGE(PG8_SB(0, 0), b2, voffB); PG8_STAGE(PG8_SB(0, 1), b2 + hstepB, voffB); PG8_STAGE(PG8_SA(0, 0), a2, voffA);
            PG8_WAIT_V(8); PG8_WAIT_L(0); PG8_BAR; PG8_MMA(1, 0, At, B0); PG8_MMA(1, 1, At, B1); PG8_BAR; PG8_SCHED;
            PG8_LDB(B0, 1, 0); PG8_LDB(B1, 1, 1); PG8_SCHED; PG8_LDA(At, 1, 0); PG8_STAGE(PG8_SA(0, 1), a2 + hstepA, voffA);
            PG8_WAIT_V(8); PG8_WAIT_L(0); PG8_BAR; PG8_MMA(0, 0, At, B0); PG8_MMA(0, 1, At, B1); PG8_BAR; PG8_SCHED;
            PG8_LDA(At, 1, 1); PG8_STAGE(PG8_SB(1, 0), b3, voffB); PG8_STAGE(PG8_SB(1, 1), b3 + hstepB, voffB); PG8_STAGE(PG8_SA(1, 0), a3, voffA);
            PG8_WAIT_V(8); PG8_WAIT_L(0); PG8_BAR; PG8_MMA(1, 0, At, B0); PG8_MMA(1, 1, At, B1); PG8_BAR; PG8_SCHED;
        }
        if constexpr (ALIGN_EPI) { if (wr == 0) PG8_BAR; }
        if constexpr (!Epi::AFTER_DRAIN) { E(acc, cur, wr, wc, fr, fq, wid, lane, ui); }
        if (!has_next) break;
#pragma unroll
        for (int a = 0; a < 2; ++a)
#pragma unroll
            for (int b = 0; b < 2; ++b)
#pragma unroll
                for (int m = 0; m < 4; ++m)
#pragma unroll
                    for (int n = 0; n < 2; ++n) acc[a][b][m][n] = (f32x4){0.f, 0.f, 0.f, 0.f};
        cur = nxt; cA = nA; cB = nB; ++ui;
        if constexpr (ALIGN_EPI) { if (wr == 1) PG8_BAR; }
    }
    PG8_WAIT_V(0);
    if constexpr (!ALIGN_EPI) { if (wr == 0) PG8_BAR; }
    PG8_BAR;
    if constexpr (Epi::AFTER_DRAIN) { E(acc, cur, wr, wc, fr, fq, wid, lane, ui); }
#undef PG8_SA
#undef PG8_SB
#undef PG8_STAGE
#undef PG8_LDA
#undef PG8_LDB
#undef PG8_MMA
#undef PG8_WAIT_V
#undef PG8_WAIT_L
#undef PG8_BAR
#undef PG8_SCHED
#undef PG8_UA
#undef PG8_UB
}
}

namespace att {
typedef LAS const char* lds_cptr;
typedef short v4i16_t __attribute__((ext_vector_type(4)));
typedef int v4i32_t __attribute__((ext_vector_type(4)));
typedef int i32x16_t __attribute__((ext_vector_type(16)));
constexpr int STAGE = 65536, KV = 64;
__device__ __forceinline__ void glds16(const void* gsrc, unsigned lds_dst) { unsigned keep;
    asm volatile("s_mov_b32 %0, m0\n\ts_mov_b32 m0, %2\n\ts_nop 0\n\tglobal_load_lds_dwordx4 %1, off\n\ts_mov_b32 m0, %0" : "=&s"(keep) : "v"(gsrc), "s"(lds_dst) : "memory"); }
__device__ __forceinline__ v4i16_t vtr(lds_cptr p) { return __builtin_amdgcn_ds_read_tr16_b64_v4i16((LAS v4i16_t*)p); }
typedef float f32x2_t __attribute__((ext_vector_type(2))); typedef __bf16 bf16x2_t __attribute__((ext_vector_type(2)));
__device__ __forceinline__ unsigned cvtpk_s(float lo, float hi) { f32x2_t v = {lo, hi}; bf16x2_t b = __builtin_convertvector(v, bf16x2_t); return __builtin_bit_cast(unsigned, b); }
#define ATT_WAIT_BAR() asm volatile("s_waitcnt vmcnt(0) lgkmcnt(0)\n\ts_barrier" ::: "memory")

template <int IDX> __device__ __forceinline__ void dma_piece(unsigned kvo, unsigned vvo, const char* kbn, const char* vbn, unsigned kdn, unsigned vdn) {
    unsigned keep, tv;
    if constexpr (IDX < 4) {
        constexpr int dl = (IDX & 1) * 16 + (IDX >> 1) * 256; const unsigned dst = kdn + (IDX & 1) * 0x400 + (IDX >> 1) * 0x4000;
        asm volatile("s_mov_b32 %0, m0\n\ts_mov_b32 m0, %3\n\tv_add_u32 %1, %4, %2\n\ts_nop 0\n\tglobal_load_lds_dwordx4 %1, %5\n\ts_mov_b32 m0, %0"
                     : "=&s"(keep), "=&v"(tv) : "v"(kvo), "s"(dst), "i"(dl), "s"(kbn) : "memory");
    } else {
        constexpr int dl = (IDX - 4) * 0x8000; const unsigned dst = vdn + (IDX - 4) * 0x400;
        asm volatile("s_mov_b32 %0, m0\n\ts_mov_b32 m0, %3\n\tv_add_u32 %1, %4, %2\n\ts_nop 0\n\tglobal_load_lds_dwordx4 %1, %5\n\ts_mov_b32 m0, %0"
                     : "=&s"(keep), "=&v"(tv) : "v"(vvo), "s"(dst), "i"(dl), "s"(vbn) : "memory");
    }
}
template <bool SHIFT> __device__ __forceinline__ void attn_item(int h, int qb, const bf16_t* Q, const bf16_t* Kt, const bf16_t* V, bf16_t* O, char* shm, float lam, float osc, const float* subg, float cshift, int wv) {
    int tid_ = (wv << 6) | lane_id(); asm volatile("" : "+v"(tid_));
    const int tid = tid_, lane = tid & 63, r32 = lane & 31, hi = lane >> 5;
    const int wid = __builtin_amdgcn_readfirstlane(tid >> 6), comp = wid >> 2, w = wid & 3;
    const int q0 = qb * 128;
    const unsigned lds0 = (unsigned)(uintptr_t)shm;
    const lds_cptr shm3 = (lds_cptr)shm;
    const unsigned kvo = (unsigned)(lane * D + wid * 16) * 2u;
    const unsigned vvo = (unsigned)((lane >> 2) * D + wid * 32 + (lane & 3) * 8) * 2u;
    const char* kbase = (const char*)(Kt + h * 256);
    const char* vbase = (const char*)(V + h * 256);
    const int NT = 2 * qb + 2, NTw = 2 * qb + 1 + (w >> 1);
#define ATT_DMA(t, st) do { const char* kb_ = kbase + (size_t)(t) * (KV * D * 2); const char* vb_ = vbase + (size_t)(t) * (KV * D * 2); \
        const unsigned kd_ = (unsigned)__builtin_amdgcn_readfirstlane(lds0 + (st) + wid * 2048), vd_ = (unsigned)__builtin_amdgcn_readfirstlane(lds0 + (st) + 32768 + wid * 4096); \
        unsigned keep_, tv_; \
        asm volatile("s_nop 4\n\ts_mov_b32 %0, m0\n\ts_mov_b32 m0, %4\n\ts_nop 0\n\t" \
                     "global_load_lds_dwordx4 %2, %6\n\tv_add_u32 %1, 16, %2\n\ts_add_u32 m0, m0, 0x400\n\ts_nop 0\n\t" \
                     "global_load_lds_dwordx4 %1, %6\n\tv_add_u32 %1, 0x100, %2\n\ts_add_u32 m0, m0, 0x3c00\n\ts_nop 0\n\t" \
                     "global_load_lds_dwordx4 %1, %6\n\tv_add_u32 %1, 0x110, %2\n\ts_add_u32 m0, m0, 0x400\n\ts_nop 0\n\t" \
                     "global_load_lds_dwordx4 %1, %6\n\ts_mov_b32 m0, %5\n\ts_nop 0\n\t" \
                     "global_load_lds_dwordx4 %3, %7\n\tv_add_u32 %1, 0x8000, %3\n\ts_add_u32 m0, m0, 0x400\n\ts_nop 0\n\t" \
                     "global_load_lds_dwordx4 %1, %7\n\tv_add_u32 %1, 0x8000, %1\n\ts_add_u32 m0, m0, 0x400\n\ts_nop 0\n\t" \
                     "global_load_lds_dwordx4 %1, %7\n\tv_add_u32 %1, 0x8000, %1\n\ts_add_u32 m0, m0, 0x400\n\ts_nop 0\n\t" \
                     "global_load_lds_dwordx4 %1, %7\n\ts_mov_b32 m0, %0" \
                     : "=&s"(keep_), "=&v"(tv_) : "v"(kvo), "v"(vvo), "s"(kd_), "s"(vd_), "s"(kb_), "s"(vb_) : "memory", "scc"); } while (0)
    ATT_DMA(0, 0);
    bf16x8 qr[8];
    { const bf16_t* qp = Q + (size_t)(q0 + 32 * w + r32) * D + h * 256 + comp * 128 + hi * 8;
#pragma unroll
      for (int ks = 0; ks < 8; ++ks) qr[ks] = *(const bf16x8*)(qp + ks * 16); }
    f32x16 o[8];
#pragma unroll
    for (int d0 = 0; d0 < 8; ++d0) o[d0] = f32x16{};
    float lsum = 0.f;
    const int koff = comp * 16384 + hi * 1024 + r32 * 16;
    const int voff = 32768 + ((r32 >> 4) & 1) * 32 + (r32 & 3) * 8 + (4 * hi + ((r32 & 15) >> 2)) * 64;
#define ATT_SB() __builtin_amdgcn_sched_barrier(0)
    for (int t = 0; t < NT; ++t) {
        const int st = (t & 1) * STAGE;
        ATT_WAIT_BAR();
        const bool has_next = (t + 1 < NT);
        const char* kbn = kbase + (size_t)(t + 1) * (KV * D * 2); const char* vbn = vbase + (size_t)(t + 1) * (KV * D * 2);
        const unsigned kdn = (unsigned)__builtin_amdgcn_readfirstlane(lds0 + (STAGE - st) + wid * 2048), vdn = (unsigned)__builtin_amdgcn_readfirstlane(lds0 + (STAGE - st) + 32768 + wid * 4096);
        if (t >= NTw) { if (has_next) ATT_DMA(t + 1, STAGE - st); }
        if (t < NTw) {
            const lds_cptr kb = shm3 + st + koff;
            const lds_cptr vb = shm3 + st + voff;
#define ATT_KFRAG(i_) (*(const LAS bf16x8*)(kb + ((i_) & 7) * 2048 + ((i_) >> 3) * 512))
#define ATT_VFRAG(dst, j_) do { const v4i16_t lo_ = vtr(vb + ((j_) & 7) * 4096 + ((j_) >> 3) * 1024), hh_ = vtr(vb + ((j_) & 7) * 4096 + ((j_) >> 3) * 1024 + 512); \
        dst = (bf16x8){lo_[0], lo_[1], lo_[2], lo_[3], hh_[0], hh_[1], hh_[2], hh_[3]}; } while (0)
            f32x16 s0, s1;
            u32x4 pw[4];
            bf16x8 kf[3], vf[3];
            float sa = 0.f, sb = 0.f;
            kf[0] = ATT_KFRAG(0); kf[1] = ATT_KFRAG(1);
#pragma unroll
            for (int i = 0; i < 16; ++i) {
                if (i + 2 < 16) kf[(i + 2) % 3] = ATT_KFRAG(i + 2);
                if ((i & 3) == 2) { if (has_next) { switch (i >> 2) {
                    case 0: dma_piece<0>(kvo, vvo, kbn, vbn, kdn, vdn); break; case 1: dma_piece<1>(kvo, vvo, kbn, vbn, kdn, vdn); break;
                    case 2: dma_piece<2>(kvo, vvo, kbn, vbn, kdn, vdn); break; default: dma_piece<3>(kvo, vvo, kbn, vbn, kdn, vdn); break; } } }
                if (i == 14) ATT_VFRAG(vf[0], 0);
                if (i == 15) ATT_VFRAG(vf[1], 1);
                if (i < 8) {
                    if (i == 0) s0 = __builtin_amdgcn_mfma_f32_32x32x16_bf16(kf[0], qr[0], f32x16{}, 0, 0, 0);
                    else s0 = __builtin_amdgcn_mfma_f32_32x32x16_bf16(kf[i % 3], qr[i], s0, 0, 0, 0);
                } else {
                    const int ks = i - 8;
                    if (ks == 0) s1 = __builtin_amdgcn_mfma_f32_32x32x16_bf16(kf[i % 3], qr[0], f32x16{}, 0, 0, 0);
                    else s1 = __builtin_amdgcn_mfma_f32_32x32x16_bf16(kf[i % 3], qr[ks], s1, 0, 0, 0);
                    s0[2 * ks] = __builtin_amdgcn_exp2f(SHIFT ? s0[2 * ks] - cshift : s0[2 * ks]); s0[2 * ks + 1] = __builtin_amdgcn_exp2f(SHIFT ? s0[2 * ks + 1] - cshift : s0[2 * ks + 1]);
                    if (ks >= 1) { sa += s0[2 * ks - 2] + s0[2 * ks - 1]; pw[(ks - 1) >> 2][(ks - 1) & 3] = cvtpk_s(s0[2 * ks - 2], s0[2 * ks - 1]); }
                }
                ATT_SB();
            }
#pragma unroll
            for (int j = 0; j < 32; ++j) {
                if (j + 2 < 32) ATT_VFRAG(vf[(j + 2) % 3], j + 2);
                if ((j & 3) == 1 && j < 16) { if (has_next) { switch (4 + (j >> 2)) {
                    case 0: dma_piece<0>(kvo, vvo, kbn, vbn, kdn, vdn); break; case 1: dma_piece<1>(kvo, vvo, kbn, vbn, kdn, vdn); break;
                    case 2: dma_piece<2>(kvo, vvo, kbn, vbn, kdn, vdn); break; case 3: dma_piece<3>(kvo, vvo, kbn, vbn, kdn, vdn); break;
                    case 4: dma_piece<4>(kvo, vvo, kbn, vbn, kdn, vdn); break; case 5: dma_piece<5>(kvo, vvo, kbn, vbn, kdn, vdn); break;
                    case 6: dma_piece<6>(kvo, vvo, kbn, vbn, kdn, vdn); break; default: dma_piece<7>(kvo, vvo, kbn, vbn, kdn, vdn); break; } } }
                o[j & 7] = __builtin_amdgcn_mfma_f32_32x32x16_bf16(vf[j % 3], __builtin_bit_cast(bf16x8, pw[j >> 3]), o[j & 7], 0, 0, 0);
                if (j == 0) { sa += s0[14] + s0[15]; pw[1][3] = cvtpk_s(s0[14], s0[15]); }
                if (j < 16) s1[j] = __builtin_amdgcn_exp2f(SHIFT ? s1[j] - cshift : s1[j]);
                if (j >= 1 && j < 17) sb += s1[j - 1];
                if (j >= 2 && j < 18 && !(j & 1)) pw[2 + ((j - 2) >> 3)][((j - 2) & 7) >> 1] = cvtpk_s(s1[j - 2], s1[j - 1]);
                ATT_SB();
            }
            lsum += sa + sb;
#undef ATT_KFRAG
#undef ATT_VFRAG
        }
    }
#undef ATT_SB
    const float l = xor32_sum(lsum);
    const float inv = 1.0f / l;
    ATT_WAIT_BAR();
    LAS f32x4* X = (LAS f32x4*)shm;
    if (comp == 1) {
        const float sc = inv * lam;
#pragma unroll
        for (int d0 = 0; d0 < 8; ++d0)
#pragma unroll
            for (int r4 = 0; r4 < 4; ++r4)
                { X[(w * 32 + d0 * 4 + r4) * 64 + lane] = (f32x4){o[d0][4 * r4] * sc, o[d0][4 * r4 + 1] * sc, o[d0][4 * r4 + 2] * sc, o[d0][4 * r4 + 3] * sc}; __builtin_amdgcn_sched_barrier(0); }
    }
    ATT_WAIT_BAR();
    if (comp == 0) {
        float ss = 0.f;
#pragma unroll
        for (int d0 = 0; d0 < 8; ++d0)
#pragma unroll
            for (int r4 = 0; r4 < 4; ++r4) {
                const f32x4 x = X[(w * 32 + d0 * 4 + r4) * 64 + lane];
#pragma unroll
                for (int i = 0; i < 4; ++i) { const float dd = o[d0][4 * r4 + i] * inv - x[i]; o[d0][4 * r4 + i] = dd; ss += dd * dd; }
                if (r4 == 3) __builtin_amdgcn_sched_barrier(0);
            }
        ss = xor32_sum(ss);
        const float rstd = __builtin_amdgcn_rsqf(ss * (1.0f / 256.0f) + NORM_EPS) * osc;
        bf16_t* orow = O + (size_t)(q0 + 32 * w + r32) * D + h * 256 + 4 * hi;
#pragma unroll
        for (int d0 = 0; d0 < 8; ++d0)
#pragma unroll
            for (int r4 = 0; r4 < 4; ++r4) {
                const int dv = 32 * d0 + 8 * r4;
                const f32x4 g4 = *(const f32x4*)(subg + dv + 4 * hi);
                u32x2 wv; wv.x = cvt_pk_bf16(o[d0][4 * r4] * rstd * g4[0], o[d0][4 * r4 + 1] * rstd * g4[1]); wv.y = cvt_pk_bf16(o[d0][4 * r4 + 2] * rstd * g4[2], o[d0][4 * r4 + 3] * rstd * g4[3]);
                *(u32x2*)(orow + dv) = wv;
                if (r4 == 3) __builtin_amdgcn_sched_barrier(0);
            }
    }
    ATT_WAIT_BAR();
#undef ATT_DMA
}

template <int IDX> __device__ __forceinline__ void dma_piece2(unsigned kvo, unsigned vvo, const char* kbn, const char* vbn, unsigned kdn, unsigned vdn) {
    unsigned keep, tv;
    if constexpr (IDX < 2) {
        constexpr int dl = IDX * 16; const unsigned dst = kdn + IDX * 0x400;
        asm volatile("s_mov_b32 %0, m0\n\ts_mov_b32 m0, %3\n\tv_add_u32 %1, %4, %2\n\ts_nop 0\n\tglobal_load_lds_dwordx4 %1, %5\n\ts_mov_b32 m0, %0"
                     : "=&s"(keep), "=&v"(tv) : "v"(kvo), "s"(dst), "i"(dl), "s"(kbn) : "memory");
    } else {
        constexpr int dl = (IDX - 2) * 0x8000; const unsigned dst = vdn + (IDX - 2) * 0x400;
        asm volatile("s_mov_b32 %0, m0\n\ts_mov_b32 m0, %3\n\tv_add_u32 %1, %4, %2\n\ts_nop 0\n\tglobal_load_lds_dwordx4 %1, %5\n\ts_mov_b32 m0, %0"
                     : "=&s"(keep), "=&v"(tv) : "v"(vvo), "s"(dst), "i"(dl), "s"(vbn) : "memory");
    }
}
template <bool SHIFT, bool LATE> __device__ __forceinline__ void attn_item2(int h, int comp, int qb, const bf16_t* Q, const bf16_t* Kt, const bf16_t* V, bf16_t* O, char* shm, float oscale, float cshift, int wv) {
    constexpr int STG = 49152, VOFF = 16384;
    int tid_ = (wv << 6) | lane_id(); asm volatile("" : "+v"(tid_));
    const int tid = tid_, lane = tid & 63, r32 = lane & 31, hi = lane >> 5;
    const int wid = __builtin_amdgcn_readfirstlane(tid >> 6);
    const int q0 = qb * 256;
    const unsigned lds0 = (unsigned)(uintptr_t)shm;
    const lds_cptr shm3 = (lds_cptr)shm;
    const unsigned kvo = (unsigned)(lane * D + wid * 16);
    const unsigned vvo = (unsigned)((lane >> 2) * D + wid * 32 + (lane & 3) * 8) * 2u;
    const char* kbase = (const char*)Kt + h * 256 + comp * 128;
    const char* vbase = (const char*)(V + h * 256);
    const int NT = 4 * qb + 4, NTw = 4 * qb + 1 + (wv >> 1);
    {
        const unsigned kd0 = (unsigned)__builtin_amdgcn_readfirstlane(lds0 + wid * 1024), vd0 = (unsigned)__builtin_amdgcn_readfirstlane(lds0 + VOFF + wid * 4096);
        dma_piece2<0>(kvo, vvo, kbase, vbase, kd0, vd0); dma_piece2<2>(kvo, vvo, kbase, vbase, kd0, vd0);
        dma_piece2<3>(kvo, vvo, kbase, vbase, kd0, vd0); dma_piece2<4>(kvo, vvo, kbase, vbase, kd0, vd0); dma_piece2<5>(kvo, vvo, kbase, vbase, kd0, vd0);
    }
    v4i32_t qr[4];
    { const unsigned char* qp = (const unsigned char*)Q + (size_t)(q0 + 32 * wid + r32) * D + h * 256 + comp * 128 + hi * 16;
#pragma unroll
      for (int ks = 0; ks < 4; ++ks) qr[ks] = *(const v4i32_t*)(qp + ks * 32); }
    f32x16 o[8];
#pragma unroll
    for (int d0 = 0; d0 < 8; ++d0) o[d0] = f32x16{};
    float lsum = 0.f;
    const int koff = hi * 1024 + r32 * 16;
    const int voff = VOFF + ((r32 >> 4) & 1) * 32 + (r32 & 3) * 8 + (4 * hi + ((r32 & 15) >> 2)) * 64;
#define ATT_SB() __builtin_amdgcn_sched_barrier(0)
#define ATT_EXPI(ia_) __builtin_amdgcn_exp2f(SHIFT ? __builtin_fmaf((float)(ia_), 1.0f / 8192.0f, -cshift) : (float)(ia_) * (1.0f / 8192.0f))
#define ATT_KFRAG(i_) (*(const LAS v4i32_t*)(kb + ((i_) & 3) * 2048 + ((i_) >> 2) * 512))
#define ATT_VFRAG(dst, vb_, j_) do { const v4i16_t lo_ = vtr((vb_) + ((j_) & 7) * 4096 + ((j_) >> 3) * 1024), hh_ = vtr((vb_) + ((j_) & 7) * 4096 + ((j_) >> 3) * 1024 + 512); \
        dst = (bf16x8){lo_[0], lo_[1], lo_[2], lo_[3], hh_[0], hh_[1], hh_[2], hh_[3]}; } while (0)
#define ATT_P2(ix) dma_piece2<ix>(kvo, vvo, kbn, vbn, kdn, vdn)
#define ATT_QK_PVA(PRE) do { \
            const lds_cptr kb = shm3 + st + koff; const lds_cptr vb = shm3 + st + voff; \
            f32x16 s0, s1; i32x16_t ia0, ia1; float sa = 0.f, sb = 0.f; v4i32_t kf[3]; \
            kf[0] = ATT_KFRAG(0); kf[1] = ATT_KFRAG(1); \
            _Pragma("unroll") for (int i = 0; i < 8; ++i) { \
                if (i + 2 < 8) kf[(i + 2) % 3] = ATT_KFRAG(i + 2); \
                if (i == 6) ATT_VFRAG(vf[0], vb, 0); \
                if (i == 7) ATT_VFRAG(vf[1], vb, 1); \
                if (i < 4) { \
                    if (i == 0) ia0 = __builtin_amdgcn_mfma_i32_32x32x32_i8(kf[0], qr[0], i32x16_t{}, 0, 0, 0); \
                    else ia0 = __builtin_amdgcn_mfma_i32_32x32x32_i8(kf[i % 3], qr[i], ia0, 0, 0, 0); \
                } else { \
                    const int ks = i - 4; \
                    if (ks == 0) ia1 = __builtin_amdgcn_mfma_i32_32x32x32_i8(kf[i % 3], qr[0], i32x16_t{}, 0, 0, 0); \
                    else ia1 = __builtin_amdgcn_mfma_i32_32x32x32_i8(kf[i % 3], qr[ks], ia1, 0, 0, 0); \
                    _Pragma("unroll") for (int e = 0; e < 4; ++e) s0[4 * ks + e] = ATT_EXPI(ia0[4 * ks + e]); \
                    if (ks >= 1) { sa += (s0[4 * ks - 4] + s0[4 * ks - 3]) + (s0[4 * ks - 2] + s0[4 * ks - 1]); \
                        pw[(2 * ks - 2) >> 2][(2 * ks - 2) & 3] = cvtpk_s(s0[4 * ks - 4], s0[4 * ks - 3]); pw[(2 * ks - 1) >> 2][(2 * ks - 1) & 3] = cvtpk_s(s0[4 * ks - 2], s0[4 * ks - 1]); } \
                } \
                ATT_SB(); \
            } \
            _Pragma("unroll") for (int j = 0; j < 16; ++j) { \
                if (j + 2 < 16 || (PRE)) ATT_VFRAG(vf[(j + 2) % 3], vb, j + 2); \
                if (j == 1) { if (has_next) ATT_P2(0); } \
                if (j == 4) { if (has_next) ATT_P2(2); } \
                if (j == 7) { if (has_next) ATT_P2(3); } \
                if (j == 10) { if (has_next) ATT_P2(4); } \
                if (j == 13) { if (has_next) ATT_P2(5); } \
                o[j & 7] = __builtin_amdgcn_mfma_f32_32x32x16_bf16(vf[j % 3], __builtin_bit_cast(bf16x8, pw[j >> 3]), o[j & 7], 0, 0, 0); \
                if (j == 0) { sa += (s0[12] + s0[13]) + (s0[14] + s0[15]); pw[1][2] = cvtpk_s(s0[12], s0[13]); pw[1][3] = cvtpk_s(s0[14], s0[15]); } \
                s1[j] = ATT_EXPI(ia1[j]); \
                if (j >= 1) sb += s1[j - 1]; \
                if (j >= 2 && !(j & 1)) pw[2 + ((j - 2) >> 3)][((j - 2) & 7) >> 1] = cvtpk_s(s1[j - 2], s1[j - 1]); \
                ATT_SB(); \
            } \
            sb += s1[15]; pw[3][3] = cvtpk_s(s1[14], s1[15]); \
            lsum += sa + sb; \
            ATT_SB(); \
        } while (0)
#define ATT_PVB(vb_, PRO) do { \
            if (PRO) { ATT_VFRAG(vf[16 % 3], (vb_), 16); ATT_VFRAG(vf[17 % 3], (vb_), 17); } \
            __builtin_amdgcn_s_setprio(1);        \
            _Pragma("unroll") for (int j = 16; j < 32; ++j) { \
                if (j + 2 < 32) ATT_VFRAG(vf[(j + 2) % 3], (vb_), j + 2); \
                o[j & 7] = __builtin_amdgcn_mfma_f32_32x32x16_bf16(vf[j % 3], __builtin_bit_cast(bf16x8, pw[j >> 3]), o[j & 7], 0, 0, 0); \
                ATT_SB(); \
            } \
            __builtin_amdgcn_s_setprio(0); \
        } while (0)
    u32x4 pw[4];
    bf16x8 vf[3];
    constexpr bool late = LATE;
    int st = 0, stp = 2 * STG, stn = STG;
    for (int t = 0; t < NT; ++t) {
        ATT_WAIT_BAR();
        const bool has_next = (t + 1 < NT);
        const char* kbn = kbase + (size_t)(t + 1) * (KV * D); const char* vbn = vbase + (size_t)(t + 1) * (KV * D * 2);
        const unsigned kdn = (unsigned)__builtin_amdgcn_readfirstlane(lds0 + stn + wid * 1024), vdn = (unsigned)__builtin_amdgcn_readfirstlane(lds0 + stn + VOFF + wid * 4096);
        if (late) { if (t >= 1 && t - 1 < NTw) ATT_PVB(shm3 + stp + voff, true); }
        if (t < NTw) ATT_QK_PVA(false);
        else if (has_next) { ATT_P2(0); ATT_P2(2); ATT_P2(3); ATT_P2(4); ATT_P2(5); }
        if (!late) { if (t < NTw) ATT_PVB(shm3 + st + voff, true); }
        stp = st; st = stn; stn = (stn == 2 * STG) ? 0 : stn + STG;
    }
    if (late) { if (NT - 1 < NTw) ATT_PVB(shm3 + stp + voff, true); }
#undef ATT_SB
#undef ATT_EXPI
#undef ATT_KFRAG
#undef ATT_VFRAG
#undef ATT_P2
#undef ATT_QK_PVA
#undef ATT_PVB
    const float sc = oscale / xor32_sum(lsum);
    ATT_WAIT_BAR();
    LAS unsigned char* stg = (LAS unsigned char*)shm + wid * 16896;
#pragma unroll
    for (int d0 = 0; d0 < 8; ++d0)
#pragma unroll
        for (int r4 = 0; r4 < 4; ++r4) {
            const int dv = 32 * d0 + 8 * r4 + 4 * hi;
            u32x2 wv2; wv2.x = cvt_pk_bf16(o[d0][4 * r4] * sc, o[d0][4 * r4 + 1] * sc); wv2.y = cvt_pk_bf16(o[d0][4 * r4 + 2] * sc, o[d0][4 * r4 + 3] * sc);
            *(LAS u32x2*)(stg + r32 * 528 + dv * 2) = wv2;
            if (r4 == 3) __builtin_amdgcn_sched_barrier(0);
        }
    asm volatile("s_waitcnt lgkmcnt(0)" ::: "memory");
    bf16_t* obase = O + (size_t)(q0 + 32 * wid) * D + h * 256 + (lane & 31) * 8;
#pragma unroll
    for (int i = 0; i < 16; ++i) {
        const int row = 2 * i + (lane >> 5);
        const u32x4 v = *(const LAS u32x4*)(stg + row * 528 + (lane & 31) * 16);
        *(u32x4*)(obase + (size_t)row * D) = v;
    }
    ATT_WAIT_BAR();
}
}

struct Args { const float* in[16]; float* out; unsigned char* ws; float invf[16]; };

__device__ __forceinline__ float wave_sum(float v) {
#pragma unroll
    for (int o = 1; o < 64; o <<= 1) v += __shfl_xor(v, o);
    return v;
}
__device__ __forceinline__ float wave_max(float v) {
#pragma unroll
    for (int o = 1; o < 64; o <<= 1) v = fmaxf(v, __shfl_xor(v, o));
    return v;
}
__device__ __forceinline__ unsigned f2bf(float f) { unsigned u = __builtin_bit_cast(unsigned, f); return (u + 0x7fffu + ((u >> 16) & 1u)) >> 16; }
__device__ __forceinline__ unsigned pk2(float lo, float hi) { return f2bf(lo) | (f2bf(hi) << 16); }

__device__ __forceinline__ void p0_transpose_item(const float* W, int K, int N, bf16_t* WT, int dest_row0, const float* gk, LAS float* scr, int k0, int n0, int lane) {
    float wv_[32];
    const float* wp = W + (size_t)(k0 + (lane >> 5)) * N + n0 + (lane & 31);
#pragma unroll
    for (int i = 0; i < 32; ++i) wv_[i] = wp[(size_t)(2 * i) * N];
    if (gk) {
#pragma unroll
        for (int i = 0; i < 32; ++i) wv_[i] *= gk[k0 + 2 * i + (lane >> 5)];
    }
#pragma unroll
    for (int i = 0; i < 32; ++i) scr[(2 * i + (lane >> 5)) * 33 + (lane & 31)] = wv_[i];
    asm volatile("s_waitcnt lgkmcnt(0)" ::: "memory");
    const int c = lane & 7;
#pragma unroll
    for (int j = 0; j < 4; ++j) { const int n = (lane >> 3) + 8 * j; const LAS float* s = scr + (8 * c) * 33 + n;
        u32x4 o; o.x = cvt_pk_bf16(s[0 * 33], s[1 * 33]); o.y = cvt_pk_bf16(s[2 * 33], s[3 * 33]); o.z = cvt_pk_bf16(s[4 * 33], s[5 * 33]); o.w = cvt_pk_bf16(s[6 * 33], s[7 * 33]);
        *(u32x4*)(WT + (size_t)(dest_row0 + n) * K + k0 + 8 * c) = o; }
    asm volatile("s_waitcnt lgkmcnt(0)" ::: "memory");
}

__device__ __forceinline__ void sincos_d(float angf, float& sn, float& cs) {
    const double a = (double)angf;
    const double n = rint(a * 0.63661977236758134308);
    double r = fma(-n, 1.57079632679489655800, a); r = fma(-n, 6.12323399573676603587e-17, r);
    const int q = ((int)n) & 3;
    const double r2 = r * r;
    const double sp = r * (1.0 + r2 * (-1.0 / 6 + r2 * (1.0 / 120 + r2 * (-1.0 / 5040 + r2 * (1.0 / 362880 + r2 * (-1.0 / 39916800 + r2 * (1.0 / 6227020800.0)))))));
    const double cp = 1.0 + r2 * (-0.5 + r2 * (1.0 / 24 + r2 * (-1.0 / 720 + r2 * (1.0 / 40320 + r2 * (-1.0 / 3628800 + r2 * (1.0 / 479001600.0 + r2 * (-1.0 / 87178291200.0)))))));
    const double s_ = (q == 0) ? sp : (q == 1) ? cp : (q == 2) ? -sp : -cp;
    const double c_ = (q == 0) ? cp : (q == 1) ? -sp : (q == 2) ? -cp : sp;
    sn = (float)s_; cs = (float)c_;
}

__device__ __forceinline__ void pooled_tile(const bf16_t* up, bf16_t* pooled, int pm, int g, int tid) {
    asm volatile("" : "+v"(tid));
    const int col = 256 * g + 8 * (tid & 31), wdw = 2 << g, t0 = 256 * pm + 16 * (tid >> 5);
    f32x4 sA = {0.f, 0.f, 0.f, 0.f}, sB = {0.f, 0.f, 0.f, 0.f};
    for (int i = 1; i <= wdw; ++i) { const int t = t0 - i; if (t >= 0) { f32x4 a, b; unpack8(*(const u32x4*)(up + (size_t)t * D + col), a, b); sA += a; sB += b; } }
#pragma unroll 4
    for (int tt = 0; tt < 16; ++tt) {
        const int t = t0 + tt;
        f32x4 ca, cb; unpack8(*(const u32x4*)(up + (size_t)t * D + col), ca, cb);
        sA += ca; sB += cb;
        if (t - wdw >= 0) { f32x4 a, b; unpack8(*(const u32x4*)(up + (size_t)(t - wdw) * D + col), a, b); sA -= a; sB -= b; }
        const float rc = 1.0f / (float)((t + 1 < wdw) ? (t + 1) : wdw);
        *(u32x4*)(pooled + (size_t)t * D + col) = pack8(sA * rc - ca, sB * rc - cb);
    }
}

__device__ __forceinline__ void fill_rstd(LAS float* xl, const float* ssq, const pg8::StaticOrder& S, int tid) {
    if (tid < 256) {
#pragma unroll
        for (int i = 0; i < 6; ++i) { pg8::Unit u; if (S.next(i, u)) { const int r = u.pm * 256 + tid;
            xl[XL_BYTES / 4 + i * 256 + tid] = __builtin_amdgcn_rsqf(((ssq[r] + ssq[M + r]) + (ssq[2 * M + r] + ssq[3 * M + r])) * (1.0f / 1024.0f) + NORM_EPS); } }
    }
    __syncthreads();
}
typedef const __attribute__((address_space(4))) Args* KArgsPtr;
#define KARGS(ap) KArgsPtr ap = (KArgsPtr)__builtin_amdgcn_kernarg_segment_ptr(); asm volatile("" : "+s"(ap))

__global__ void __launch_bounds__(NTHREADS, 2) fwd_megakernel(Args args_unused) {
    extern __shared__ __attribute__((aligned(16))) unsigned char lds_raw[];
    cg::grid_group grid = cg::this_grid();
    LAS unsigned char* lds = (LAS unsigned char*)lds_raw;
    LAS float* xl = (LAS float*)(lds + XL_OFF);
    const int wv = __builtin_amdgcn_readfirstlane(threadIdx.x >> 6);
    volatile LAS unsigned* bst = (volatile LAS unsigned*)(lds + LDS_BYTES - 16);
    if (wv == 0) { if (lane_id() == 0) { bst[0] = 0u; bst[1] = 0u; KARGS(ap0); (void)xb_add((unsigned*)(ap0->ws + WS_BAR) + XB_XCNT(xb_xcc_id()), 1u); } }
    __syncthreads();
#define GRID_BAR() do { KARGS(apb); grid_barrier((unsigned*)(apb->ws + WS_BAR), bst, wv); } while (0)
    if (gridDim.x == 0x7fffffffu) grid.sync();

    {
        KARGS(ap);
        unsigned char* ws = ap->ws;
        const int bx = blockIdx.x, G = gridDim.x, vcu = (bx % 8) * (G / 8) + bx / 8;
        int tid = (wv << 6) | lane_id(); asm volatile("" : "+v"(tid));
        const int lane = tid & 63, wave = wv;
        LAS float* scr = (LAS float*)(lds + wave * 16384);
        const int gw = vcu * NWAVES + wave, NGW = G * NWAVES;
        constexpr int I_IN = 16 * 192, I_OUT = 16 * 32, I_FF = 16 * 176, I_FO = 44 * 32, I_PL = 128, I_LAYER = I_IN + I_OUT + I_FF + I_FO + I_PL;
        for (int it = gw; it < DEPTH * I_LAYER; it += NGW) {
            const int L = it / I_LAYER; int r = it % I_LAYER;
            unsigned char* wl = ws + WS_W + (size_t)L * LAYER_W;
            if (r < I_IN) { const int kb = r / 192, nb = r % 192;
                p0_transpose_item(ap->in[2] + (size_t)L * D * NIN, D, NIN, (bf16_t*)(wl + OFF_WIN), 32 * nb, ap->in[1] + L * D, scr, 64 * kb, 32 * nb, lane); continue; }
            r -= I_IN;
            if (r < I_OUT) { const int kb = r / 32, nb = r % 32;
                p0_transpose_item(ap->in[12] + (size_t)L * D * D, D, D, (bf16_t*)(wl + OFF_WOUT), 32 * nb, nullptr, scr, 64 * kb, 32 * nb, lane); continue; }
            r -= I_OUT;
            if (r < I_FF) { const int kb = r / 176, nb = r % 176; const int n0 = 32 * nb, up = (n0 >= FF) ? 1 : 0, j = n0 - up * FF;
                p0_transpose_item(ap->in[14] + (size_t)L * D * NFF2, D, NFF2, (bf16_t*)(wl + OFF_WFF), 256 * (j / 128) + 128 * up + (j % 128), ap->in[13] + L * D, scr, 64 * kb, n0, lane); continue; }
            r -= I_FF;
            if (r < I_FO) { const int kb = r / 32, nb = r % 32;
                p0_transpose_item(ap->in[15] + (size_t)L * FF * D, FF, D, (bf16_t*)(wl + OFF_WFO), 32 * nb, nullptr, scr, 64 * kb, 32 * nb, lane); continue; }
            r -= I_FO;
            { const int gg = r / 32, rr = r % 32, kb = rr / 8, nb = rr % 8;
                p0_transpose_item(ap->in[10] + (size_t)L * 4 * 65536 + (size_t)gg * 65536, 256, 256, (bf16_t*)(wl + OFF_POOL) + (size_t)gg * 65536, 32 * nb, nullptr, scr, 64 * kb, 32 * nb, lane); }
        }
        const float* x_in = ap->in[0];
        bf16_t* xb = (bf16_t*)(ws + WS_XB); float* ssq = (float*)(ws + WS_SSQ);
        for (int m = gw; m < M; m += NGW) {
            const f32x4* xr = (const f32x4*)(x_in + (size_t)m * D) + lane;
            float s = 0.f;
#pragma unroll
            for (int j = 0; j < 4; ++j) { const f32x4 v = xr[64 * j]; s += (v[0] * v[0] + v[1] * v[1]) + (v[2] * v[2] + v[3] * v[3]);
                u32x2 w2; w2.x = cvt_pk_bf16(v[0], v[1]); w2.y = cvt_pk_bf16(v[2], v[3]); *((u32x2*)(xb + (size_t)m * D) + lane + 64 * j) = w2; }
            s = wave_sum(s);
            if (lane < 4) ssq[(size_t)lane * M + m] = (lane == 0) ? s : 0.f;
        }
        float* rcos = (float*)(ws + WS_COS); float* rsin = (float*)(ws + WS_SIN);
        for (int idx = vcu * NTHREADS + tid; idx < M * 16; idx += G * NTHREADS) {
            const int pos = idx >> 4, j = idx & 15;
            const float ang = (float)pos * ap->invf[j];
            float sn, cs; sincos_d(ang, sn, cs);
            rcos[idx] = cs; rsin[idx] = sn;
        }
    }
    GRID_BAR();

#pragma unroll 1
    for (int L = 0; L < DEPTH; ++L) {
        {
            KARGS(ap); unsigned char* ws = ap->ws; unsigned char* wl = ws + WS_W + (size_t)L * LAYER_W;
            pg8::Gemm g{(const bf16_t*)(ws + WS_XB), (const bf16_t*)(wl + OFF_WIN), D, D, D, 0};
            int bxl = blockIdx.x; asm volatile("" : "+s"(bxl)); pg8::StaticOrder S; S.init(M, NIN, GRID, bxl);
            pg8::EpiIn E{ws, ap->in[3] + L * 128, ap->in[4] + L * 128, xl};
            fill_rstd(xl, (const float*)(ws + WS_SSQ), S, (wv << 6) | lane_id());
            pg8::gemm_phase<pg8::EpiIn, true>(lds, g, S, E, wv);
        }
        GRID_BAR();
        {
            KARGS(ap); unsigned char* ws = ap->ws;
            int ln = lane_id(); asm volatile("" : "+v"(ln));
            const float lam_init = 0.8f - 0.6f * expf(-0.3f * (float)L);
            const float* lq1 = ap->in[5] + L * 128; const float* lk1 = ap->in[6] + L * 128; const float* lq2 = ap->in[7] + L * 128; const float* lk2 = ap->in[8] + L * 128;
            const float d1 = wave_sum_rl(lq1[ln] * lk1[ln] + lq1[ln + 64] * lk1[ln + 64]);
            const float d2 = wave_sum_rl(lq2[ln] * lk2[ln] + lq2[ln + 64] * lk2[ln + 64]);
            const float lam = expf(d1) - expf(d2) + lam_init;
            const float* gq = ap->in[3] + L * 128; const float* gk = ap->in[4] + L * 128;
            const float mq = wave_max_rl(fmaxf(fabsf(gq[ln]), fabsf(gq[ln + 64]))), mk = wave_max_rl(fmaxf(fabsf(gk[ln]), fabsf(gk[ln + 64])));
            const float cshift = 11.313708498984761f * 1.4426950408889634f * mq * mk;
            int bx = blockIdx.x; asm volatile("" : "+s"(bx)); const int vcu = (bx % 8) * (GRID / 8) + bx / 8;
            const int hc = vcu >> 5, p = vcu & 31, h = hc >> 1, comp = hc & 1;
            const bf16_t* act0 = (const bf16_t*)(ws + WS_ACT);
            const bf16_t* Qb = act0 + ACT_ELEMS; const bf16_t* Kb = act0 + 2 * ACT_ELEMS; const bf16_t* Vb = act0 + 3 * ACT_ELEMS;
            bf16_t* Oc = (bf16_t*)(ws + (comp ? WS_XB : WS_ATTN));
            const float oscale = comp ? lam : 1.0f;
            if (cshift <= 64.0f) {
                if (wv >= 4) { att::attn_item2<false, true>(h, comp, 63 - p, Qb, Kb, Vb, Oc, (char*)lds_raw, oscale, 0.0f, wv); att::attn_item2<false, true>(h, comp, p, Qb, Kb, Vb, Oc, (char*)lds_raw, oscale, 0.0f, wv); }
                else         { att::attn_item2<false, false>(h, comp, 63 - p, Qb, Kb, Vb, Oc, (char*)lds_raw, oscale, 0.0f, wv); att::attn_item2<false, false>(h, comp, p, Qb, Kb, Vb, Oc, (char*)lds_raw, oscale, 0.0f, wv); }
            } else {
                if (wv >= 4) { att::attn_item2<true, true>(h, comp, 63 - p, Qb, Kb, Vb, Oc, (char*)lds_raw, oscale, cshift, wv); att::attn_item2<true, true>(h, comp, p, Qb, Kb, Vb, Oc, (char*)lds_raw, oscale, cshift, wv); }
                else         { att::attn_item2<true, false>(h, comp, 63 - p, Qb, Kb, Vb, Oc, (char*)lds_raw, oscale, cshift, wv); att::attn_item2<true, false>(h, comp, p, Qb, Kb, Vb, Oc, (char*)lds_raw, oscale, cshift, wv); }
            }
        }
        GRID_BAR();
        {
            KARGS(ap); unsigned char* ws = ap->ws; unsigned char* wl = ws + WS_W + (size_t)L * LAYER_W;
            bf16_t* act0 = (bf16_t*)(ws + WS_ACT);
            int bxl = blockIdx.x; asm volatile("" : "+s"(bxl)); pg8::StaticOrder S; S.init(M, D, GRID, bxl);
            pg8::Unit u;
            (void)S.next(0, u); pooled_tile(act0, (bf16_t*)(ws + WS_POOLED), u.pm, u.pn, (wv << 6) | lane_id());
            asm volatile("s_waitcnt vmcnt(0)" ::: "memory");
            __syncthreads();
            pg8::Gemm g{(const bf16_t*)(ws + WS_POOLED), (const bf16_t*)(wl + OFF_POOL), D, 256, 256, 256};
            pg8::EpiMerge E{act0 + 4 * ACT_ELEMS, act0 + 5 * ACT_ELEMS, (const bf16_t*)(ws + WS_ATTN), (const bf16_t*)(ws + WS_XB), ap->in[11] + L * D, ap->in[9] + L * 256, (bf16_t*)(ws + WS_MERGED),
                            1.0f - (0.8f - 0.6f * expf(-0.3f * (float)L)), xl};
            pg8::gemm_phase<pg8::EpiMerge, false>(lds, g, S, E, wv);
        }
        GRID_BAR();
        {
            KARGS(ap); unsigned char* ws = ap->ws; unsigned char* wl = ws + WS_W + (size_t)L * LAYER_W;
            pg8::Gemm g{(const bf16_t*)(ws + WS_MERGED), (const bf16_t*)(wl + OFF_WOUT), D, D, D, 0};
            int bxl = blockIdx.x; asm volatile("" : "+s"(bxl)); pg8::StaticOrder S; S.init(M, D, GRID, bxl);
            pg8::EpiRes E{(L == 0) ? ap->in[0] : (const float*)ap->out, ap->out, (bf16_t*)(ws + WS_XB), (float*)(ws + WS_SSQ), lds};
            pg8::gemm_phase<pg8::EpiRes, false>(lds, g, S, E, wv);
        }
        GRID_BAR();
        {
            KARGS(ap); unsigned char* ws = ap->ws; unsigned char* wl = ws + WS_W + (size_t)L * LAYER_W;
            pg8::Gemm g{(const bf16_t*)(ws + WS_XB), (const bf16_t*)(wl + OFF_WFF), D, D, D, 0};
            int bxl = blockIdx.x; asm volatile("" : "+s"(bxl)); pg8::StaticOrder S; S.init(M, NFF2, GRID, bxl);
            pg8::EpiSwiGLU E{(bf16_t*)(ws + WS_FFACT), xl};
            fill_rstd(xl, (const float*)(ws + WS_SSQ), S, (wv << 6) | lane_id());
            pg8::gemm_phase<pg8::EpiSwiGLU, true>(lds, g, S, E, wv);
        }
        GRID_BAR();
        {
            KARGS(ap); unsigned char* ws = ap->ws; unsigned char* wl = ws + WS_W + (size_t)L * LAYER_W;
            pg8::Gemm g{(const bf16_t*)(ws + WS_FFACT), (const bf16_t*)(wl + OFF_WFO), FF, FF, FF, 0};
            int bxl = blockIdx.x; asm volatile("" : "+s"(bxl)); pg8::StaticOrder S; S.init(M, D, GRID, bxl);
            pg8::EpiRes E{(const float*)ap->out, ap->out, (bf16_t*)(ws + WS_XB), (float*)(ws + WS_SSQ), lds};
            pg8::gemm_phase<pg8::EpiRes, false>(lds, g, S, E, wv);
        }
        if (L + 1 < DEPTH) GRID_BAR();
    }
}

extern "C" void kernel_launch(void* const* d_in, const int* in_sizes, int n_in, void* d_out, int out_size, void* d_ws, size_t ws_size, hipStream_t stream) {
    static int ready = 0;
    if (ready == 0) {
        if (n_in != 16 || in_sizes[0] != M * D || out_size != M * D || ws_size < WS_END) {
            fprintf(stderr, "kernel_launch: unexpected shapes (n_in %d, in0 %d, out %d, ws %zu < %zu); nothing launched\n", n_in, n_in > 0 ? in_sizes[0] : -1, out_size, ws_size, (size_t)WS_END); ready = -1; return; }
        if (hipFuncSetAttribute((const void*)fwd_megakernel, hipFuncAttributeMaxDynamicSharedMemorySize, LDS_BYTES) != hipSuccess) { fprintf(stderr, "kernel_launch: hipFuncSetAttribute failed\n"); ready = -1; return; }
        int dev = 0, cus = 0, per_cu = 0;
        (void)hipGetDevice(&dev); (void)hipDeviceGetAttribute(&cus, hipDeviceAttributeMultiprocessorCount, dev);
        (void)hipOccupancyMaxActiveBlocksPerMultiprocessor(&per_cu, (const void*)fwd_megakernel, NTHREADS, LDS_BYTES);
        if (cus * per_cu < GRID) fprintf(stderr, "kernel_launch: note: %d CUs x %d blocks/CU < grid %d\n", cus, per_cu, GRID);
        (void)hipGetLastError();
        ready = 1;
    }
    if (ready < 0) return;
    if (hipMemsetAsync((char*)d_ws + WS_BAR, 0, WS_BAR_BYTES, stream) != hipSuccess) { fprintf(stderr, "kernel_launch: hipMemsetAsync failed\n"); return; }
    Args a{};
    for (int i = 0; i < 16; ++i) a.in[i] = (const float*)d_in[i];
    a.out = (float*)d_out; a.ws = (unsigned char*)d_ws;
    for (int j = 0; j < 16; ++j) a.invf[j] = (float)pow(500000.0, -(double)j / 16.0);
    void* kargs[] = {&a};
    hipError_t e = hipLaunchCooperativeKernel((const void*)fwd_megakernel, dim3(GRID), dim3(NTHREADS), kargs, LDS_BYTES, stream);
    if (e != hipSuccess) fprintf(stderr, "kernel_launch: cooperative launch failed: %s\n", hipGetErrorString(e));
}
```
